# Optimizing an MI355X kernel written in HIP

```python
import math
import jax, jax.numpy as jnp
from jax import lax
import numpy as np

D_MODEL = 4096
BATCH = 16
SEQ = 256
DEPTH = 2
DEC_BATCH = 8
DEC_SEQ = 2048
PAST_LEN = 512

GRID_W = 64
N_GROUPS = 4
GROUP_W = D_MODEL // N_GROUPS
HEAD_DIM = 128
NA_HEADS = GROUP_W // HEAD_DIM
DIFF_HEADS = GROUP_W // (2 * HEAD_DIM)
RET_HEADS = GROUP_W // HEAD_DIM
NA_KH = 8
NA_KW = 16
Q_BLOCK = 128
RET_CHUNK = 128
CONV_K = 3
ROPE_BASE = 10000.0
IN_PARTS = 16
D_IN = IN_PARTS * GROUP_W
ALPHA = (2 * DEPTH) ** 0.25
BETA = (8 * DEPTH) ** -0.25
LN_EPS = 1e-6
NEG_INF = -1e30

kernel_name = 'hybrid_diffusion_prefix_trunk'

F32 = jnp.float32


def _layer_norm(x):
    xf = x.astype(F32)
    mu = xf.mean(-1, keepdims=True)
    var = jnp.square(xf - mu).mean(-1, keepdims=True)
    return ((xf - mu) * lax.rsqrt(var + LN_EPS)).astype(x.dtype)


def _rms_norm(x, g):
    xf = x.astype(F32)
    return (xf * lax.rsqrt(jnp.mean(xf * xf, -1, keepdims=True) + LN_EPS)).astype(x.dtype) * g


def _rope_half(x, ang):
    m = x.shape[-1] // 2
    cos = jnp.cos(ang).astype(x.dtype)
    sin = jnp.sin(ang).astype(x.dtype)
    x1, x2 = x[..., :m], x[..., m:]
    return jnp.concatenate([x1 * cos - x2 * sin, x2 * cos + x1 * sin], -1)


def _axial_rope(x):
    L, d = x.shape[1], x.shape[-1]
    half = d // 2
    nf = half // 2
    t = jnp.arange(L)
    inv = ROPE_BASE ** (-jnp.arange(nf, dtype=F32) / nf)
    shape = (L,) + (1,) * (x.ndim - 3) + (nf,)
    ang_r = ((t // GRID_W).astype(F32)[:, None] * inv).reshape(shape)
    ang_c = ((t % GRID_W).astype(F32)[:, None] * inv).reshape(shape)
    return jnp.concatenate([_rope_half(x[..., :half], ang_r), _rope_half(x[..., half:], ang_c)], -1)


def _split_q_blocks(q):
    B, L = q.shape[:2]
    return jnp.moveaxis(q.reshape((B, L // Q_BLOCK, Q_BLOCK) + q.shape[2:]), 1, 0)


def _merge_q_blocks(o):
    nb, B = o.shape[:2]
    return jnp.moveaxis(o, 0, 1).reshape((B, nb * Q_BLOCK) + o.shape[3:])


def _softmax_attention(q, k, v):
    scale = q.shape[-1] ** -0.5

    def block(qb):
        s = jnp.einsum('bqhd,bkhd->bhqk', qb, k).astype(F32) * scale
        p = jax.nn.softmax(s, -1).astype(v.dtype)
        return jnp.einsum('bhqk,bkhe->bqhe', p, v)

    return _merge_q_blocks(lax.map(block, _split_q_blocks(q)))


def _diff_attention(q, k, v, lam):
    scale = q.shape[-1] ** -0.5

    def block(qb):
        s = jnp.einsum('bqhtd,bkhtd->bthqk', qb, k).astype(F32) * scale
        p = jax.nn.softmax(s, -1)
        a = (p[:, 0] - lam * p[:, 1]).astype(v.dtype)
        return jnp.einsum('bhqk,bkhe->bqhe', a, v)

    return _merge_q_blocks(lax.map(block, _split_q_blocks(q)))


def _neighbourhood_attention(q, k, v, ck, cv, rel_bias):
    B, L, H, d = q.shape
    rows = L // GRID_W
    kh = min(NA_KH, rows)
    scale = d ** -0.5
    r = jnp.arange(rows)
    row_idx = jnp.clip(r - kh // 2, 0, rows - kh)[:, None] + jnp.arange(kh)[None, :]
    col = jnp.arange(GRID_W)
    c0 = jnp.clip(col - NA_KW // 2, 0, GRID_W - NA_KW)
    col_ok = (col[None, :] >= c0[:, None]) & (col[None, :] < c0[:, None] + NA_KW)
    dr = row_idx - r[:, None] + NA_KH - 1
    dc = jnp.clip(col[None, :] - col[:, None] + NA_KW - 1, 0, 2 * NA_KW - 2)
    bias = rel_bias[:, dr[:, None, :, None], dc[None, :, None, :]]
    bias = jnp.swapaxes(bias, 0, 1).astype(F32)
    qg = q.reshape(B, rows, GRID_W, H, d)
    kg = k.reshape(B, rows, GRID_W, H, d)[:, row_idx]
    vg = v.reshape(B, rows, GRID_W, H, d)[:, row_idx]
    s_loc = jnp.einsum('brqhd,brkwhd->brhqkw', qg, kg).astype(F32) * scale + bias
    s_loc = jnp.where(col_ok[:, None, :], s_loc, NEG_INF).reshape(B, rows, H, GRID_W, kh * GRID_W)
    s_ctx = jnp.einsum('brqhd,bchd->brhqc', qg, ck).astype(F32) * scale
    p = jax.nn.softmax(jnp.concatenate([s_loc, s_ctx], -1), -1).astype(v.dtype)
    p_loc = p[..., :kh * GRID_W].reshape(B, rows, H, GRID_W, kh, GRID_W)
    p_ctx = p[..., kh * GRID_W:]
    o = (jnp.einsum('brhqkw,brkwhd->brqhd', p_loc, vg)
         + jnp.einsum('brhqc,bchd->brqhd', p_ctx, cv))
    return o.reshape(B, L, H, d)


def _retention_scan(q, k, v, log_gamma, s0):
    B, L, H, _ = q.shape
    dv = v.shape[-1]
    nc = L // RET_CHUNK
    idx = jnp.arange(RET_CHUNK, dtype=F32)
    lg = log_gamma[:, None]
    diff = idx[:, None] - idx[None, :]
    dmat = jnp.where(diff >= 0, jnp.exp(jnp.maximum(diff, 0.0)[None] * lg[:, :, None]), 0.0)
    q_decay = jnp.exp((idx + 1.0)[None] * lg).T
    k_decay = jnp.exp((RET_CHUNK - 1.0 - idx)[None] * lg).T
    chunk_decay = jnp.exp(RET_CHUNK * log_gamma)

    def chunks(t):
        return jnp.moveaxis(t.astype(F32).reshape(B, nc, RET_CHUNK, H, t.shape[-1]), 1, 0)

    def step(S, inp):
        qc, kc, vc = inp
        a = jnp.einsum('bihd,bjhd->bhij', qc, kc) * dmat
        o = (jnp.einsum('bhij,bjhe->bihe', a, vc)
             + jnp.einsum('bihd,bhde->bihe', qc, S) * q_decay[None, :, :, None])
        S = (S * chunk_decay[None, :, None, None]
             + jnp.einsum('bjhd,bjhe->bhde', kc * k_decay[None, :, :, None], vc))
        return S, o

    S, o = lax.scan(step, s0, (chunks(q), chunks(k), chunks(v)))
    o = jnp.moveaxis(o, 0, 1).reshape(B, L, H, dv).astype(v.dtype)
    return o, S


def _bidir_retention(q, k, v, log_decay, s0):
    o_f, s_f = _retention_scan(q, k, v, log_decay[0], s0[:, 0])
    o_b, s_b = _retention_scan(jnp.flip(q, 1), jnp.flip(k, 1), jnp.flip(v, 1), log_decay[1], s0[:, 1])
    return o_f + jnp.flip(o_b, 1), jnp.stack([s_f, s_b], 1)


def _short_conv(u, w):
    up = jnp.pad(u, ((0, 0), (1, 1), (0, 0)))
    return up[:, :-2] * w[:, 0] + up[:, 1:-1] * w[:, 1] + up[:, 2:] * w[:, 2]


def _layer(x, cvec, w_in, w_out, w_ada, b_ada, ln_g, ln_b, na_bias, diff_lam, diff_subln,
           ret_decay, conv_w, lam_init, ctx=None):
    B, L, _ = x.shape
    m = (jax.nn.silu(cvec) @ w_ada + b_ada)[:, None, :]
    shift, scale, gate = jnp.split(m, 3, -1)
    h = _layer_norm(x) * (1 + scale) + shift
    p = jnp.einsum('bld,de->ble', h, w_in)
    (aq, ak, av, ag, bq, bk, bv, bg, rq, rk, rv, rg, dh, db, dcg, dg) = jnp.split(p, IN_PARTS, -1)
    aq = aq.reshape(B, L, NA_HEADS, HEAD_DIM)
    ak = ak.reshape(B, L, NA_HEADS, HEAD_DIM)
    av = av.reshape(B, L, NA_HEADS, HEAD_DIM)
    bq = bq.reshape(B, L, DIFF_HEADS, 2, HEAD_DIM)
    bk = bk.reshape(B, L, DIFF_HEADS, 2, HEAD_DIM)
    bv = bv.reshape(B, L, DIFF_HEADS, 2 * HEAD_DIM)
    lf = diff_lam.astype(F32)
    lam = jnp.exp(jnp.sum(lf[0] * lf[1])) - jnp.exp(jnp.sum(lf[2] * lf[3])) + lam_init
    rq = rq.reshape(B, L, RET_HEADS, HEAD_DIM)
    rk = rk.reshape(B, L, RET_HEADS, HEAD_DIM) * (HEAD_DIM ** -0.5)
    rv = rv.reshape(B, L, RET_HEADS, HEAD_DIM)
    log_decay = jax.nn.log_sigmoid(ret_decay.astype(F32))
    if ctx is None:
        a_out = _softmax_attention(aq, ak, av)
        b_out = _diff_attention(bq, bk, bv, lam)
        s0 = jnp.zeros((B, 2, RET_HEADS, HEAD_DIM, HEAD_DIM), F32)
    else:
        c_na_k, c_na_v, c_df_k, c_df_v, c_st = ctx
        a_out = _neighbourhood_attention(aq, ak, av, c_na_k, c_na_v, na_bias)
        bq_r = _axial_rope(bq)
        bk_r = _axial_rope(bk)
        b_out = _diff_attention(bq_r, jnp.concatenate([c_df_k, bk_r], 1),
                                jnp.concatenate([c_df_v, bv], 1), lam)
        rq = _axial_rope(rq)
        rk = _axial_rope(rk)
        s0 = c_st.astype(F32)
    r_out, r_state = _bidir_retention(rq, rk, rv, log_decay, s0)
    r_out = _layer_norm(r_out)
    b_out = _rms_norm(b_out, diff_subln) * (1.0 - lam_init)
    d_out = db * _short_conv(dcg * dh, conv_w)
    y = jnp.concatenate([
        jax.nn.silu(ag) * a_out.reshape(B, L, GROUP_W),
        jax.nn.silu(bg) * b_out.reshape(B, L, GROUP_W),
        jax.nn.silu(rg) * r_out.reshape(B, L, GROUP_W),
        jax.nn.silu(dg) * d_out], -1)
    y = jnp.einsum('ble,ed->bld', y, w_out)
    x = _layer_norm(ALPHA * x + gate * y) * ln_g + ln_b
    if ctx is None:
        return x, (ak, av, bk, bv, r_state.astype(x.dtype))
    return x, None


def setup_inputs(seed: int = 0) -> dict:
    key = jax.random.key(seed)
    ks = jax.random.split(key, 22)
    n = jax.random.normal
    ret_base = jnp.log(2.0 ** (5.0 + jnp.arange(RET_HEADS, dtype=F32)) - 1.0)
    return {
        'x_prompt': n(ks[0], (BATCH, SEQ, D_MODEL), F32),
        'x_sample': n(ks[1], (DEC_BATCH, DEC_SEQ, D_MODEL), F32),
        'cache_na_k': n(ks[2], (DEC_BATCH, DEPTH, PAST_LEN, NA_HEADS, HEAD_DIM), F32),
        'cache_na_v': n(ks[3], (DEC_BATCH, DEPTH, PAST_LEN, NA_HEADS, HEAD_DIM), F32),
        'cache_diff_k': n(ks[4], (DEC_BATCH, DEPTH, PAST_LEN, DIFF_HEADS, 2, HEAD_DIM), F32),
        'cache_diff_v': n(ks[5], (DEC_BATCH, DEPTH, PAST_LEN, DIFF_HEADS, 2 * HEAD_DIM), F32),
        'state_ret': n(ks[6], (DEC_BATCH, DEPTH, 2, RET_HEADS, HEAD_DIM, HEAD_DIM), F32),
        'c': n(ks[7], (DEC_BATCH, D_MODEL), F32),
        'c_ctx': n(ks[8], (D_MODEL,), F32),
        'w_ada': n(ks[9], (DEPTH, D_MODEL, 3 * D_MODEL), F32) * D_MODEL ** -0.5,
        'b_ada': n(ks[10], (DEPTH, 3 * D_MODEL), F32) * 0.01,
        'w_in': n(ks[11], (DEPTH, D_MODEL, D_IN), F32) * D_MODEL ** -0.5,
        'w_out': n(ks[12], (DEPTH, D_MODEL, D_MODEL), F32) * (D_MODEL ** -0.5 * BETA),
        'ln_g': 1.0 + 0.01 * n(ks[13], (DEPTH, D_MODEL), F32),
        'ln_b': 0.01 * n(ks[14], (DEPTH, D_MODEL), F32),
        'na_bias': 0.1 * n(ks[15], (DEPTH, NA_HEADS, 2 * NA_KH - 1, 2 * NA_KW - 1), F32),
        'diff_lam': 0.1 * n(ks[16], (DEPTH, 4, HEAD_DIM), F32),
        'diff_subln': 1.0 + 0.01 * n(ks[17], (DEPTH, 2 * HEAD_DIM), F32),
        'ret_decay': ret_base + 0.1 * n(ks[18], (DEPTH, 2, RET_HEADS), F32),
        'conv_w': n(ks[19], (DEPTH, GROUP_W, CONV_K), F32) * CONV_K ** -0.5,
    }


def reference(x_prompt, x_sample, cache_na_k, cache_na_v, cache_diff_k, cache_diff_v, state_ret,
              c, c_ctx, w_ada, b_ada, w_in, w_out, ln_g, ln_b, na_bias, diff_lam, diff_subln,
              ret_decay, conv_w):
    y_p = x_prompt
    y_s = x_sample
    nk, nv, dk, dv, st = [], [], [], [], []
    for l in range(DEPTH):
        lam_init = 0.8 - 0.6 * math.exp(-0.3 * l)
        w = (w_in[l], w_out[l], w_ada[l], b_ada[l], ln_g[l], ln_b[l], na_bias[l], diff_lam[l],
             diff_subln[l], ret_decay[l], conv_w[l], lam_init)
        y_p, (k_a, v_a, k_b, v_b, s_r) = _layer(y_p, c_ctx[None], *w)
        nk.append(k_a)
        nv.append(v_a)
        dk.append(k_b)
        dv.append(v_b)
        st.append(s_r)
        ctx = (cache_na_k[:, l], cache_na_v[:, l], cache_diff_k[:, l], cache_diff_v[:, l], state_ret[:, l])
        y_s, _ = _layer(y_s, c, *w, ctx=ctx)
    new_na_k = jnp.stack(nk, 1)
    new_na_v = jnp.stack(nv, 1)
    new_diff_k = jnp.stack(dk, 1)
    new_diff_v = jnp.stack(dv, 1)
    new_state_ret = jnp.stack(st, 1)
    return (y_p, y_s, new_na_k, new_na_v, new_diff_k, new_diff_v, new_state_ret)
```

```cpp
#include <hip/hip_runtime.h>
#include <cstdio>
#include <cstdint>
namespace pg8 {
#define PG8_LAS __attribute__((address_space(3)))
typedef unsigned short bf16_t;
typedef short bf16x8 __attribute__((ext_vector_type(8)));
typedef float f32x4 __attribute__((ext_vector_type(4)));
typedef unsigned u32x4 __attribute__((ext_vector_type(4)));
typedef unsigned u32x2 __attribute__((ext_vector_type(2)));
constexpr int BM = 256, BK = 64, HALF = 128, HTB = HALF * BK * 2, STAGE_BYTES = 8 * HTB, NXCD = 8, WGM = 8;

__host__ __device__ __forceinline__ int lds_byte(int r, int c) { const int st = (r >> 4) * 2 + (c >> 5), rr = r & 15, cc = c & 31, ob = rr * 64 + cc * 2; return st * 1024 + (ob ^ (((ob >> 9) & 1) << 5)); }
__host__ __device__ __forceinline__ void stage_rc(int b, int& R, int& C) { const int st = b / 1024, sb = b % 1024, swz = sb ^ (((sb >> 9) & 1) << 5); R = (st >> 1) * 16 + swz / 64; C = (st & 1) * 32 + (swz % 64) / 2; }
__host__ __device__ __forceinline__ int perm32(int rho) { const int n = rho >> 4, i = rho & 15; return 8 * (i >> 2) + 4 * n + (i & 3); }
__host__ __device__ __forceinline__ int ropemap(int R) { const int wc = R >> 5, n = (R >> 4) & 1, j = R & 15; return 64 * (wc >> 1) + 32 * n + 16 * (wc & 1) + j; }

struct Unit { int pm, pn; };
struct Gemm { const bf16_t* A; const bf16_t* Bt; };

template <int M_, int N_> struct StaticOrder {
    static constexpr int nM = M_ / BM, nN = N_ / BM, nwg = nM * nN;
    int G, c;
    __host__ __device__ void init(int G_, int c_) { G = G_; c = c_; }
    __host__ __device__ bool next(int i, Unit& u) const {
        const int L = i * G + c; if (L >= nwg) return false;
        int wgid = L; { constexpr int q = nwg / NXCD, r = nwg % NXCD; const int xcd = wgid % NXCD, off = wgid / NXCD; wgid = (xcd < r ? xcd * (q + 1) : r * (q + 1) + (xcd - r) * q) + off; }
        constexpr int nig = WGM * nN; const int gid = wgid / nig, fm = gid * WGM, gsz = (nM - fm) < WGM ? (nM - fm) : WGM;
        u.pm = fm + ((wgid % nig) % gsz); u.pn = (wgid % nig) / gsz; return true;
    }
    __device__ __forceinline__ void a_ready(const Unit&) const {}
    __device__ __forceinline__ void done(const Unit&) const {}
};

template <int M_, int N_> struct SyncOrder {
    static constexpr int nM = M_ / BM, nN = N_ / BM, nwg = nM * nN;
    static_assert(nM == 80 && nN % 16 == 0, "SyncOrder is laid out for 80 row panels");
    int G, c;
    __host__ __device__ void init(int G_, int c_) { G = G_; c = c_; }
    __host__ __device__ bool next(int i, Unit& u) const {
        if (G != 256) { const int L = i * G + c; if (L >= nwg) return false; u.pm = L / nN; u.pn = L % nN; return true; }
        const int x = c & 7, sl = c >> 3;
#ifndef SYNC_ORDER_COLS
#define SYNC_ORDER_COLS 1
#endif
        if (SYNC_ORDER_COLS) {
            constexpr int cpx = nN / 8, rpr = 32 / cpx;
            if (i >= nM / rpr) return false;
            u.pn = cpx * x + (sl % cpx); u.pm = rpr * i + (sl / cpx); return true;
        }
        if (i < nN / 4) { u.pm = 8 * x + (sl & 7); u.pn = 4 * i + (sl >> 3); return true; }
        const int i2 = i - nN / 4; if (i2 >= nN / 16) return false;
        u.pm = 64 + 2 * x + (sl & 1); u.pn = 16 * i2 + (sl >> 1); return true;
    }
    __device__ __forceinline__ void a_ready(const Unit&) const {}
    __device__ __forceinline__ void done(const Unit&) const {}
};

__device__ __forceinline__ const char* uni_ptr(const char* p) { const unsigned long long v = (unsigned long long)p; const unsigned lo = __builtin_amdgcn_readfirstlane((unsigned)v), hi = __builtin_amdgcn_readfirstlane((unsigned)(v >> 32)); return (const char*)(((unsigned long long)hi << 32) | lo); }
__device__ __forceinline__ unsigned cvt_pk_bf16(float lo, float hi) { unsigned r; asm volatile("v_cvt_pk_bf16_f32 %0, %1, %2" : "=v"(r) : "v"(lo), "v"(hi)); return r; }

struct EpiIn {
    static constexpr bool PERM = true, ROPE = true, AFTER_DRAIN = false;
    bf16_t* P; const float* rope;
    __device__ __forceinline__ void operator()(const f32x4 (&acc)[2][2][4][2], const Unit& u, int wr, int wc, int fr, int fq) const {
        const int row0 = u.pm * BM + wr * 64 + fr; const int g = u.pn >> 2;
        const int hsel = wc >> 1, f0 = 16 * (wc & 1) + 4 * fq;
        const int colh = u.pn * BM + 64 * hsel + 16 * (wc & 1) + 4 * fq;
        const bool roped = u.pm >= 16 && (g == 4 || g == 5 || g == 8 || g == 9);
        f32x4 ccv[2][4], ssv[2][4];
#pragma unroll
        for (int ai = 0; ai < 2; ++ai)
#pragma unroll
            for (int m = 0; m < 4; ++m) { ccv[ai][m] = (f32x4){1.f, 1.f, 1.f, 1.f}; ssv[ai][m] = (f32x4){0.f, 0.f, 0.f, 0.f}; }
        if (roped) {
#pragma unroll
            for (int ai = 0; ai < 2; ++ai)
#pragma unroll
                for (int m = 0; m < 4; ++m) { const int row = row0 + ai * HALF + m * 16; const int t = (row - 4096) & 2047; const int pos = hsel ? (t & 63) : (t >> 6);
                    const f32x4 cs0 = *(const f32x4*)(rope + (pos * 32 + f0) * 2), cs1 = *(const f32x4*)(rope + (pos * 32 + f0) * 2 + 4);
                    ccv[ai][m] = (f32x4){cs0[0], cs0[2], cs1[0], cs1[2]}; ssv[ai][m] = (f32x4){cs0[1], cs0[3], cs1[1], cs1[3]}; }
        }
#pragma unroll
        for (int ai = 0; ai < 2; ++ai)
#pragma unroll
            for (int m = 0; m < 4; ++m) {
                const int row = row0 + ai * HALF + m * 16;
                const f32x4 cc = ccv[ai][m], ss = ssv[ai][m];
                bf16_t* rowp = P + (size_t)row * 16384 + colh + ((fq & 1) ? 28 : 0);
#pragma unroll
                for (int bj = 0; bj < 2; ++bj) { const f32x4 x1 = acc[ai][bj][m][0], x2 = acc[ai][bj][m][1];
                    const f32x4 o1 = x1 * cc - x2 * ss, o2 = x2 * cc + x1 * ss;
                    const unsigned w1x = cvt_pk_bf16(o1[0], o1[1]), w1y = cvt_pk_bf16(o1[2], o1[3]), w2x = cvt_pk_bf16(o2[0], o2[1]), w2y = cvt_pk_bf16(o2[2], o2[3]);
                    const auto r0 = __builtin_amdgcn_permlane16_swap(w1x, w2x, false, false), r1 = __builtin_amdgcn_permlane16_swap(w1y, w2y, false, false);
                    u32x4 w; w.x = r0[0]; w.y = r1[0]; w.z = r0[1]; w.w = r1[1];
                    *(u32x4*)(rowp + bj * HALF) = w; }
            }
    }
};

struct EpiOut {
    static constexpr bool PERM = true, ROPE = false, AFTER_DRAIN = false;
    bf16_t* O; const float* mod;
    __device__ __forceinline__ void operator()(const f32x4 (&acc)[2][2][4][2], const Unit& u, int wr, int wc, int fr, int fq) const {
        const int row0 = u.pm * BM + wr * 64 + fr, col0 = u.pn * BM + wc * 32 + 8 * fq;
        const int vec = u.pm < 16 ? 8 : ((u.pm - 16) >> 3);
        const float* gate = mod + (size_t)vec * 12288 + 8192 + col0;
        f32x4 gv[2][2];
#pragma unroll
        for (int bj = 0; bj < 2; ++bj)
#pragma unroll
            for (int n = 0; n < 2; ++n) gv[bj][n] = *(const f32x4*)(gate + bj * HALF + 4 * n);
#pragma unroll
        for (int ai = 0; ai < 2; ++ai)
#pragma unroll
            for (int m = 0; m < 4; ++m) { bf16_t* rowp = O + (size_t)(row0 + ai * HALF + m * 16) * 4096 + col0;
#pragma unroll
                for (int bj = 0; bj < 2; ++bj) { const f32x4 v0 = acc[ai][bj][m][0] * gv[bj][0], v1 = acc[ai][bj][m][1] * gv[bj][1];
                    u32x4 w; w.x = cvt_pk_bf16(v0[0], v0[1]); w.y = cvt_pk_bf16(v0[2], v0[3]); w.z = cvt_pk_bf16(v1[0], v1[1]); w.w = cvt_pk_bf16(v1[2], v1[3]);
                    *(u32x4*)(rowp + bj * HALF) = w; } }
    }
};

template <class Epi, class Sched, int K, bool ALIGN_EPI = true, bool SP2 = true>
__device__ __forceinline__ void gemm_phase(PG8_LAS unsigned char* lds, const Gemm g, const Sched& S, const Epi& E, const int tid) {
    const int wid = __builtin_amdgcn_readfirstlane(tid >> 6), lane = tid & 63, wr = wid >> 2, wc = wid & 3, fr = lane & 15, fq = lane >> 4;
    constexpr int nt = K / BK;
    unsigned voffA[2], voffB[2];
#pragma unroll
    for (int i = 0; i < 2; ++i) { int R, C; stage_rc(tid * 16 + i * 8192, R, C); const int Rb = Epi::ROPE ? ropemap(R) : (Epi::PERM ? ((R & ~31) + perm32(R & 31)) : R);
        voffA[i] = (unsigned)(R * K + C) * 2u; voffB[i] = (unsigned)(Rb * K + C) * 2u; }
    constexpr size_t kstep = (size_t)(BK * 2);
    constexpr size_t hstep = (size_t)HALF * K * 2;
    constexpr size_t tstep = 2 * hstep;
    const unsigned ldsw = (unsigned)wid * 1024u;
    const int aoff = lds_byte(wr * 64 + fr, fq * 8), boff = lds_byte(wc * 32 + fr, fq * 8);
#define PG8_SA(b, h) (((b) * 2 + (h)) * HTB)
#define PG8_SB(b, h) ((4 + (b) * 2 + (h)) * HTB)
#define PG8_STAGE(bufoff, gbase, voff) do { _Pragma("unroll") for (int _i = 0; _i < 2; ++_i) \
        __builtin_amdgcn_global_load_lds((const unsigned*)((const char*)(gbase) + (voff)[_i]), (PG8_LAS unsigned*)(lds + (bufoff) + ldsw + _i * 8192), 16, 0, 0); } while (0)
#ifndef PG8_B_AUX
#define PG8_B_AUX 0
#endif
#define PG8_STAGEB(bufoff, gbase, voff) do { _Pragma("unroll") for (int _i = 0; _i < 2; ++_i) \
        __builtin_amdgcn_global_load_lds((const unsigned*)((const char*)(gbase) + (voff)[_i]), (PG8_LAS unsigned*)(lds + (bufoff) + ldsw + _i * 8192), 16, 0, PG8_B_AUX); } while (0)
#define PG8_LDA(dst, b, h) do { _Pragma("unroll") for (int m = 0; m < 4; ++m) _Pragma("unroll") for (int k = 0; k < 2; ++k) dst[m][k] = *(const PG8_LAS bf16x8*)(lds + PG8_SA(b, h) + aoff + m * 2048 + k * 1024); } while (0)
#define PG8_LDB(dst, b, h) do { _Pragma("unroll") for (int n = 0; n < 2; ++n) _Pragma("unroll") for (int k = 0; k < 2; ++k) dst[n][k] = *(const PG8_LAS bf16x8*)(lds + PG8_SB(b, h) + boff + n * 2048 + k * 1024); } while (0)
#define PG8_MMA(ai, bj, At, Bt) do { __builtin_amdgcn_s_setprio(1); _Pragma("unroll") for (int m = 0; m < 4; ++m) _Pragma("unroll") for (int n = 0; n < 2; ++n) _Pragma("unroll") for (int k = 0; k < 2; ++k) \
        acc[ai][bj][m][n] = __builtin_amdgcn_mfma_f32_16x16x32_bf16(Bt[n][k], At[m][k], acc[ai][bj][m][n], 0, 0, 0); __builtin_amdgcn_s_setprio(0); } while (0)
#define PG8_WAIT_V(n) asm volatile("s_waitcnt vmcnt(" #n ")" ::: "memory")
#define PG8_WAIT_L(n) asm volatile("s_waitcnt lgkmcnt(" #n ")" ::: "memory")
#define PG8_BAR __builtin_amdgcn_s_barrier()
#define PG8_SCHED __builtin_amdgcn_sched_barrier(0)
    Unit cur, nxt; int ui = 0;
    if (!S.next(0, cur)) return;
    f32x4 acc[2][2][4][2];
#pragma unroll
    for (int a = 0; a < 2; ++a)
#pragma unroll
        for (int b = 0; b < 2; ++b)
#pragma unroll
            for (int m = 0; m < 4; ++m)
#pragma unroll
                for (int n = 0; n < 2; ++n) acc[a][b][m][n] = (f32x4){0.f, 0.f, 0.f, 0.f};
    bf16x8 At[4][2], B0[2][2], B1[2][2];
    const char* cA = (const char*)g.A + (size_t)cur.pm * tstep; const char* cB = (const char*)g.Bt + (size_t)cur.pn * tstep;
    S.a_ready(cur);
    if constexpr (SP2) {
        PG8_STAGEB(PG8_SB(0, 0), cB, voffB); PG8_STAGEB(PG8_SB(0, 1), cB + hstep, voffB); PG8_STAGE(PG8_SA(0, 0), cA, voffA); PG8_STAGE(PG8_SA(0, 1), cA + hstep, voffA);
        if (wr == 1) PG8_BAR;
        PG8_WAIT_V(2); PG8_BAR;
        PG8_STAGEB(PG8_SB(1, 0), cB + kstep, voffB); PG8_STAGE(PG8_SA(1, 0), cA + kstep, voffA); PG8_STAGEB(PG8_SB(1, 1), cB + hstep + kstep, voffB);
        PG8_WAIT_V(6); PG8_BAR;
    } else {
        PG8_STAGEB(PG8_SB(0, 0), cB, voffB); PG8_STAGE(PG8_SA(0, 0), cA, voffA); PG8_STAGEB(PG8_SB(0, 1), cB + hstep, voffB); PG8_STAGE(PG8_SA(0, 1), cA + hstep, voffA);
        if (wr == 1) PG8_BAR;
        PG8_WAIT_V(4); PG8_BAR;
        PG8_STAGEB(PG8_SB(1, 0), cB + kstep, voffB); PG8_STAGE(PG8_SA(1, 0), cA + kstep, voffA); PG8_STAGEB(PG8_SB(1, 1), cB + hstep + kstep, voffB);
        PG8_WAIT_V(6); PG8_BAR;
    }
    for (;;) {
        const bool has_next = S.next(ui + 1, nxt);
        const char* nA = has_next ? (const char*)g.A + (size_t)nxt.pm * tstep : cA; const char* nB = has_next ? (const char*)g.Bt + (size_t)nxt.pn * tstep : cB;
        for (int t = 0; t < nt; t += 2) {
            const bool last = (t == nt - 2);
            const char* a1 = cA + (size_t)(t + 1) * kstep;
            const char* a2 = last ? nA : cA + (size_t)(t + 2) * kstep; const char* b2 = last ? nB : cB + (size_t)(t + 2) * kstep;
            a1 = uni_ptr(a1); a2 = uni_ptr(a2); b2 = uni_ptr(b2);
            const char* a3 = a2 + kstep; const char* b3 = b2 + kstep;
            if (last && has_next) S.a_ready(nxt);
            if constexpr (SP2) {
            PG8_LDB(B0, 0, 0); PG8_LDB(B1, 0, 1); PG8_SCHED; PG8_LDA(At, 0, 0); PG8_STAGE(PG8_SA(1, 1), a1 + hstep, voffA);
            PG8_WAIT_V(8); PG8_WAIT_L(0); PG8_BAR; PG8_MMA(0, 0, At, B0); PG8_MMA(0, 1, At, B1); PG8_BAR; PG8_SCHED;
            PG8_LDA(At, 0, 1); PG8_STAGEB(PG8_SB(0, 0), b2, voffB); PG8_STAGEB(PG8_SB(0, 1), b2 + hstep, voffB); PG8_STAGE(PG8_SA(0, 0), a2, voffA);
            PG8_WAIT_V(8); PG8_WAIT_L(0); PG8_BAR; PG8_MMA(1, 0, At, B0); PG8_MMA(1, 1, At, B1); PG8_BAR; PG8_SCHED;
            PG8_LDB(B0, 1, 0); PG8_LDB(B1, 1, 1); PG8_SCHED; PG8_LDA(At, 1, 0); PG8_STAGE(PG8_SA(0, 1), a2 + hstep, voffA);
            PG8_WAIT_V(8); PG8_WAIT_L(0); PG8_BAR; PG8_MMA(0, 0, At, B0); PG8_MMA(0, 1, At, B1); PG8_BAR; PG8_SCHED;
            PG8_LDA(At, 1, 1); PG8_STAGEB(PG8_SB(1, 0), b3, voffB); PG8_STAGEB(PG8_SB(1, 1), b3 + hstep, voffB); PG8_STAGE(PG8_SA(1, 0), a3, voffA);
            PG8_WAIT_V(8); PG8_WAIT_L(0); PG8_BAR; PG8_MMA(1, 0, At, B0); PG8_MMA(1, 1, At, B1); PG8_BAR; PG8_SCHED;
            } else {
            PG8_LDB(B0, 0, 0); PG8_SCHED; PG8_LDA(At, 0, 0); PG8_STAGE(PG8_SA(1, 1), a1 + hstep, voffA);
            PG8_WAIT_L(8); PG8_BAR; PG8_WAIT_L(0); PG8_MMA(0, 0, At, B0); PG8_BAR; PG8_SCHED;
            PG8_LDB(B1, 0, 1); PG8_STAGEB(PG8_SB(0, 0), b2, voffB);
            PG8_BAR; PG8_WAIT_L(0); PG8_MMA(0, 1, At, B1); PG8_BAR;
            PG8_LDA(At, 0, 1); PG8_STAGE(PG8_SA(0, 0), a2, voffA);
            PG8_BAR; PG8_WAIT_L(0); PG8_MMA(1, 0, At, B0); PG8_BAR; PG8_SCHED;
            PG8_STAGEB(PG8_SB(0, 1), b2 + hstep, voffB);
            PG8_WAIT_V(6); PG8_BAR; PG8_MMA(1, 1, At, B1); PG8_BAR;
            PG8_LDB(B0, 1, 0); PG8_SCHED; PG8_LDA(At, 1, 0); PG8_STAGE(PG8_SA(0, 1), a2 + hstep, voffA);
            PG8_WAIT_L(8); PG8_BAR; PG8_WAIT_L(0); PG8_MMA(0, 0, At, B0); PG8_BAR; PG8_SCHED;
            PG8_LDB(B1, 1, 1); PG8_STAGEB(PG8_SB(1, 0), b3, voffB);
            PG8_BAR; PG8_WAIT_L(0); PG8_MMA(0, 1, At, B1); PG8_BAR;
            PG8_LDA(At, 1, 1); PG8_STAGE(PG8_SA(1, 0), a3, voffA);
            PG8_BAR; PG8_WAIT_L(0); PG8_MMA(1, 0, At, B0); PG8_BAR; PG8_SCHED;
            PG8_STAGEB(PG8_SB(1, 1), b3 + hstep, voffB);
            PG8_WAIT_V(6); PG8_BAR; PG8_MMA(1, 1, At, B1); PG8_BAR;
            }
        }
        if constexpr (ALIGN_EPI) { if (wr == 0) PG8_BAR; }
        if constexpr (!Epi::AFTER_DRAIN) { int l2_; asm volatile("v_mbcnt_lo_u32_b32 %0, -1, 0\n\tv_mbcnt_hi_u32_b32 %0, -1, %0" : "=v"(l2_)); const int fr2 = l2_ & 15, fq2 = l2_ >> 4;
            E(acc, cur, wr, wc, fr2, fq2); S.done(cur); }
        if (!has_next) break;
#pragma unroll
        for (int a = 0; a < 2; ++a)
#pragma unroll
            for (int b = 0; b < 2; ++b)
#pragma unroll
                for (int m = 0; m < 4; ++m)
#pragma unroll
                    for (int n = 0; n < 2; ++n) acc[a][b][m][n] = (f32x4){0.f, 0.f, 0.f, 0.f};
        cur = nxt; cA = nA; cB = nB; ++ui;
        if constexpr (ALIGN_EPI) { if (wr == 1) PG8_BAR; }
    }
    PG8_WAIT_V(0);
    if constexpr (!ALIGN_EPI) { if (wr == 0) PG8_BAR; }
    PG8_BAR;
#undef PG8_SA
#undef PG8_SB
#undef PG8_STAGE
#undef PG8_STAGEB
#undef PG8_LDA
#undef PG8_LDB
#undef PG8_MMA
#undef PG8_WAIT_V
#undef PG8_WAIT_L
#undef PG8_BAR
#undef PG8_SCHED
}
}
namespace att {
typedef unsigned short u16;
using bf16x8 = __attribute__((ext_vector_type(8))) short;
using s16x4  = __attribute__((ext_vector_type(4))) short;
using f32x16 = __attribute__((ext_vector_type(16))) float;
using u32x4  = __attribute__((ext_vector_type(4))) unsigned;
constexpr int   D = 128, NW = 8, QBLK = 32, KVBLK = 64;
constexpr float SCALE = 0.088388347648318440f;
constexpr float THR = 8.f;
constexpr size_t SHM_V = KVBLK * D * 2, SHM_K = KVBLK * D * 2, SHM_ATTN = 3 * SHM_V + 3 * SHM_K;
#define KSWZ(row, colB) ((row) * 256 + ((colB) ^ (((row) & 7) << 4)))
#define SBAR() __builtin_amdgcn_sched_barrier(0)
__device__ __forceinline__ int crow(int r, int hi) { return (r & 3) + 8 * (r >> 2) + 4 * hi; }
__device__ __forceinline__ unsigned cvtpk(float lo, float hi) { unsigned r; asm volatile("v_cvt_pk_bf16_f32 %0, %1, %2" : "=v"(r) : "v"(lo), "v"(hi)); return r; }
__device__ __forceinline__ bf16x8 ld8(const u16* p) { return *reinterpret_cast<const bf16x8*>(p); }
template <int X> __device__ __forceinline__ float swz_xor(float v) { return __int_as_float(__builtin_amdgcn_ds_swizzle(__float_as_int(v), (X << 10) | 0x1f)); }
__device__ __forceinline__ float sum_xor32(float v) { auto rr = __builtin_amdgcn_permlane32_swap(__float_as_uint(v), __float_as_uint(v), false, false); return __uint_as_float(rr[0]) + __uint_as_float(rr[1]); }

__device__ __forceinline__ void partialSM(f32x16& p0, f32x16& p1, float& m_reg, float& mn, float& alpha) {
  constexpr float C = SCALE * 1.4426950408889634f;
  float pmax = p0[0];
#pragma unroll
  for (int r = 1; r < 16; ++r) pmax = fmaxf(pmax, p0[r]);
#pragma unroll
  for (int r = 0; r < 16; ++r) pmax = fmaxf(pmax, p1[r]);
  { auto rr = __builtin_amdgcn_permlane32_swap(__float_as_uint(pmax), __float_as_uint(pmax), false, false);
    pmax = fmaxf(__uint_as_float(rr[0]), __uint_as_float(rr[1])); }
  if (__builtin_expect(__all(pmax - m_reg <= THR / SCALE), 1)) { mn = m_reg; alpha = 1.f; }
  else { mn = fmaxf(m_reg, pmax); alpha = __builtin_amdgcn_exp2f((m_reg - mn) * C); m_reg = mn; }
  float mnC = -mn * C;
#pragma unroll
  for (int r = 0; r < 16; ++r) p0[r] = fmaf(p0[r], C, mnC);
#pragma unroll
  for (int r = 0; r < 16; ++r) p1[r] = fmaf(p1[r], C, mnC);
#pragma unroll
  for (int r = 0; r < 16; ++r) p0[r] = __builtin_amdgcn_exp2f(p0[r]);
}
__device__ __forceinline__ void finishSM(f32x16& p0, f32x16& p1, float alpha, float& l_reg, bf16x8& pa0, bf16x8& pa1, bf16x8& pa2, bf16x8& pa3) {
#pragma unroll
  for (int r = 0; r < 16; ++r) p1[r] = __builtin_amdgcn_exp2f(p1[r]);
  float ps = 0;
#pragma unroll
  for (int r = 0; r < 16; ++r) ps += p0[r];
#pragma unroll
  for (int r = 0; r < 16; ++r) ps += p1[r];
  { auto rr = __builtin_amdgcn_permlane32_swap(__float_as_uint(ps), __float_as_uint(ps), false, false);
    ps = __uint_as_float(rr[0]) + __uint_as_float(rr[1]); }
  l_reg = l_reg * alpha + ps;
#define PK4(P, BASE, OUT) do { unsigned a0 = cvtpk(P[BASE + 0], P[BASE + 1]), a1 = cvtpk(P[BASE + 2], P[BASE + 3]);   \
    unsigned b0 = cvtpk(P[BASE + 4], P[BASE + 5]), b1 = cvtpk(P[BASE + 6], P[BASE + 7]);                              \
    auto r0 = __builtin_amdgcn_permlane32_swap(a0, b0, false, false); auto r1 = __builtin_amdgcn_permlane32_swap(a1, b1, false, false); \
    u32x4 w = {r0[0], r1[0], r0[1], r1[1]}; OUT = *reinterpret_cast<bf16x8*>(&w); } while (0)
  PK4(p0, 0, pa0); PK4(p0, 8, pa1); PK4(p1, 0, pa2); PK4(p1, 8, pa3);
#undef PK4
}
__device__ __forceinline__ void qkt(f32x16& p0, f32x16& p1, const u16* Ks, const bf16x8* qr, int r32, int hi) {
  p0 = f32x16{}; p1 = f32x16{};
#pragma unroll
  for (int d0 = 0; d0 < 8; ++d0) { int cb = (d0 * 16 + hi * 8) * 2;
    bf16x8 b0 = *reinterpret_cast<const bf16x8*>((const char*)Ks + KSWZ(r32, cb));
    bf16x8 b1 = *reinterpret_cast<const bf16x8*>((const char*)Ks + KSWZ(32 + r32, cb));
    p0 = __builtin_amdgcn_mfma_f32_32x32x16_bf16(b0, qr[d0], p0, 0, 0, 0);
    p1 = __builtin_amdgcn_mfma_f32_32x32x16_bf16(b1, qr[d0], p1, 0, 0, 0); }
}
__device__ __forceinline__ int v_st(int k, int c) { const int kk = (k & ~0xC) | ((k & 4) << 1) | ((k & 8) >> 1); return ((kk >> 3) * 4 + (c >> 5)) * 512 + ((kk & 7) * 32 + (c & 31)) * 2; }
__device__ __forceinline__ int v_rd_base(int lane) { return ((lane & 3) << 3) | (((lane >> 2) & 3) << 6) | (((lane >> 4) & 1) << 5) | (((lane >> 5) & 1) << 8); }
constexpr int v_rd_off(int d0, int ks, int half) { return d0 * 512 + ks * 4096 + half * 2048; }
template <int OFF> __device__ __forceinline__ s16x4 tr_read(int vb) {
  s16x4 r; asm volatile("ds_read_b64_tr_b16 %0, %1 offset:%2" : "=&v"(r) : "v"(vb), "i"(OFF) : "memory"); return r;
}
template <int D0> __device__ __forceinline__ void pv_one(f32x16& od, int vb, bf16x8 pa0, bf16x8 pa1, bf16x8 pa2, bf16x8 pa3) {
  const s16x4 l0 = tr_read<v_rd_off(D0, 0, 0)>(vb), h0 = tr_read<v_rd_off(D0, 0, 1)>(vb), l1 = tr_read<v_rd_off(D0, 1, 0)>(vb), h1 = tr_read<v_rd_off(D0, 1, 1)>(vb);
  const s16x4 l2 = tr_read<v_rd_off(D0, 2, 0)>(vb), h2 = tr_read<v_rd_off(D0, 2, 1)>(vb), l3 = tr_read<v_rd_off(D0, 3, 0)>(vb), h3 = tr_read<v_rd_off(D0, 3, 1)>(vb);
  asm volatile("s_waitcnt lgkmcnt(0)" ::: "memory"); SBAR();
#define PK(L, H) (bf16x8){L[0], L[1], L[2], L[3], H[0], H[1], H[2], H[3]}
  od = __builtin_amdgcn_mfma_f32_32x32x16_bf16(pa0, PK(l0, h0), od, 0, 0, 0);
  od = __builtin_amdgcn_mfma_f32_32x32x16_bf16(pa1, PK(l1, h1), od, 0, 0, 0);
  od = __builtin_amdgcn_mfma_f32_32x32x16_bf16(pa2, PK(l2, h2), od, 0, 0, 0);
  od = __builtin_amdgcn_mfma_f32_32x32x16_bf16(pa3, PK(l3, h3), od, 0, 0, 0);
#undef PK
}
__device__ __forceinline__ void pv_d0(f32x16* o, int vb, bf16x8 pa0, bf16x8 pa1, bf16x8 pa2, bf16x8 pa3) {
  pv_one<0>(o[0], vb, pa0, pa1, pa2, pa3); pv_one<1>(o[1], vb, pa0, pa1, pa2, pa3); pv_one<2>(o[2], vb, pa0, pa1, pa2, pa3); pv_one<3>(o[3], vb, pa0, pa1, pa2, pa3);
}

struct Run { const u16 *Q, *K0, *V0, *K1, *V1; int ldq, ld0, ld1, nt0, NT, na, rq0, rlo;
#ifdef PROBE_DMA0
  int probe; const u16* Kz;
#endif
};
#ifdef PROBE_DMA0
#define PROBE_JT(R, jt) ((R).probe ? 0 : (jt))
#if PROBE_DMA0 == 2
#define PROBE_Z(R, kp, vp, ld) if ((R).probe) { kp = (R).Kz; vp = (R).Kz; ld = 1024; }
#else
#define PROBE_Z(R, kp, vp, ld)
#endif
#else
#define PROBE_JT(R, jt) (jt)
#define PROBE_Z(R, kp, vp, ld)
#endif

__device__ __forceinline__ void na_apply(f32x16& p0, f32x16& p1, int rk, int rq, int cq, int hi, const __attribute__((address_space(3))) float* biasS) {
  int w0 = rq - 4; w0 = w0 < 0 ? 0 : (w0 > 24 ? 24 : w0);
  if (rk < w0 || rk >= w0 + 8) {
#pragma unroll
    for (int r = 0; r < 16; ++r) { p0[r] = -1e30f; p1[r] = -1e30f; }
    return;
  }
  int c0 = cq - 8; c0 = c0 < 0 ? 0 : (c0 > 48 ? 48 : c0);
  const __attribute__((address_space(3))) float* bl = biasS + (rk - rq + 7) * 32 + (15 - cq + 4 * hi);
  const int dd = 4 * hi - c0;
#pragma unroll
  for (int r = 0; r < 16; ++r) {
    const int kc = (r & 3) + 8 * (r >> 2);
    { const bool ok = (unsigned)(dd + kc) < 16u; const float b = bl[kc]; p0[r] = ok ? p0[r] + b : -1e30f; }
    { const bool ok = (unsigned)(dd + kc + 32) < 16u; const float b = bl[kc + 32]; p1[r] = ok ? p1[r] + b : -1e30f; }
    if ((r & 3) == 3) asm volatile("" ::: "memory");
  }
}

template <int OFF> __device__ __forceinline__ bf16x8 rd128(int addr) { bf16x8 r; asm volatile("ds_read_b128 %0, %1 offset:%2" : "=&v"(r) : "v"(addr), "i"(OFF) : "memory"); return r; }
constexpr int voff2(int g, int ks, int hf) { return (g >> 2) * 16384 + (g & 3) * 512 + ks * 4096 + hf * 2048; }
#define LGKM(n) do { asm volatile("s_waitcnt lgkmcnt(" #n ")" ::: "memory"); SBAR(); } while (0)
__device__ __forceinline__ void attn_run_w(const Run& R, char* lds, float* wsf_all, f32x16 (&o)[4], f32x16 (&o2)[4], int tid) {
  typedef __attribute__((address_space(3))) unsigned lds_u32;
  const int wid = __builtin_amdgcn_readfirstlane(tid >> 6), lane = tid & 63, r32 = lane & 31, hi = lane >> 5;
  const int gB = wid >> 2;
  u16* K_lds = (u16*)lds; u16* V_lds = (u16*)(lds + 2 * SHM_K); char* Q_lds = lds + 2 * SHM_K + 4 * SHM_V + wid * 4096;
  float* wsf = wsf_all + wid * 64; float* li_l = wsf; float* al_l = wsf + 32;
  float m_reg = -1e30f, l_reg = 0;
#pragma unroll
  for (int d = 0; d < 4; ++d) { o[d] = f32x16{}; o2[d] = f32x16{}; }
  int krow[2], kcol[2], vrow[2], vcol[2];
#pragma unroll
  for (int i = 0; i < 2; ++i) { const int b = i * 8192 + wid * 1024 + lane * 16;
    krow[i] = b >> 8; kcol[i] = ((b & 255) ^ ((krow[i] & 7) << 4)) >> 1;
    const int sub = b >> 9, kk = (sub >> 2) * 8 + ((b & 511) >> 6); vcol[i] = (sub & 3) * 32 + ((b & 63) >> 1); vrow[i] = (kk & ~0xC) | ((kk & 4) << 1) | ((kk & 8) >> 1); }
  const int vb0 = (int)(uintptr_t)V_lds + v_rd_base(lane);
  const int kb0 = (int)(uintptr_t)K_lds + r32 * 256, kxr = (r32 & 7) << 4;
  const int qa0 = (int)(uintptr_t)Q_lds + r32 * 32 + hi * 16;
#define TILEPTR(jt) const int jt_ = (jt); const u16* kp_; const u16* vp_; int ld_; \
    if (jt_ < R.nt0) { ld_ = R.ld0; kp_ = R.K0 + (long)jt_ * 64 * ld_; vp_ = R.V0 + (long)jt_ * 64 * ld_; } \
    else { ld_ = R.ld1; kp_ = R.K1 + (long)(jt_ - R.nt0) * 64 * ld_; vp_ = R.V1 + (long)(jt_ - R.nt0) * 64 * ld_; }
#define SLOADK(jt) do { TILEPTR(jt) (void)vp_; _Pragma("unroll") for (int i_ = 0; i_ < 2; ++i_) \
      __builtin_amdgcn_global_load_lds((const unsigned*)(kp_ + (krow[i_] * ld_ + kcol[i_])), (lds_u32*)((char*)K_lds + (jt_ & 1) * SHM_K + i_ * 8192 + wid * 1024), 16, 0, 0); } while (0)
#define SLOADV(jt) do { TILEPTR(jt) (void)kp_; _Pragma("unroll") for (int hf_ = 0; hf_ < 2; ++hf_) _Pragma("unroll") for (int i_ = 0; i_ < 2; ++i_) \
      __builtin_amdgcn_global_load_lds((const unsigned*)(vp_ + (vrow[i_] * ld_ + vcol[i_] + 128 * hf_)), (lds_u32*)((char*)V_lds + ((jt_ & 1) * 2 + hf_) * SHM_V + i_ * 8192 + wid * 1024), 16, 0, 0); } while (0)
  bf16x8 qr[4]; const int NT = R.NT;
  __syncthreads();
  { const u16* Qw = R.Q + (long)(wid * QBLK + r32) * R.ldq + hi * 8;
#pragma unroll
    for (int d0 = 0; d0 < 4; ++d0) qr[d0] = ld8(Qw + d0 * 16);
#pragma unroll
    for (int d0 = 4; d0 < 8; ++d0) *(bf16x8*)(Q_lds + (d0 - 4) * 1024 + r32 * 32 + hi * 16) = ld8(Qw + d0 * 16); }
  SLOADK(0); SLOADV(0); if (NT > 1) SLOADK(1);
  asm volatile("s_waitcnt vmcnt(0) lgkmcnt(0)" ::: "memory"); __syncthreads();
#define PKF(L, H) (bf16x8){L[0], L[1], L[2], L[3], H[0], H[1], H[2], H[3]}
#define TRG(F, G) do { F[0] = tr_read<voff2(G, 0, 0)>(vb); F[1] = tr_read<voff2(G, 0, 1)>(vb); F[2] = tr_read<voff2(G, 1, 0)>(vb); F[3] = tr_read<voff2(G, 1, 1)>(vb); \
      F[4] = tr_read<voff2(G, 2, 0)>(vb); F[5] = tr_read<voff2(G, 2, 1)>(vb); F[6] = tr_read<voff2(G, 3, 0)>(vb); F[7] = tr_read<voff2(G, 3, 1)>(vb); } while (0)
#define PVG(ACC, F) do { ACC = __builtin_amdgcn_mfma_f32_32x32x16_bf16(pa0, PKF(F[0], F[1]), ACC, 0, 0, 0); ACC = __builtin_amdgcn_mfma_f32_32x32x16_bf16(pa1, PKF(F[2], F[3]), ACC, 0, 0, 0); \
      ACC = __builtin_amdgcn_mfma_f32_32x32x16_bf16(pa2, PKF(F[4], F[5]), ACC, 0, 0, 0); ACC = __builtin_amdgcn_mfma_f32_32x32x16_bf16(pa3, PKF(F[6], F[7]), ACC, 0, 0, 0); } while (0)
#define KR(D0, B0, B1, QF) do { const int ka_ = kc + (((((D0) & 3) * 32) + hi * 16) ^ kxr); B0 = rd128<((D0) >> 2) * 128>(ka_); B1 = rd128<((D0) >> 2) * 128 + 8192>(ka_); \
      if ((D0) >= 4) QF = rd128<(((D0) - 4) & 3) * 1024>(qa0); } while (0)
#define QKS(D0, B0, B1, QF) do { const bf16x8 q_ = ((D0) < 4) ? qr[(D0) & 3] : QF; \
      p0 = __builtin_amdgcn_mfma_f32_32x32x16_bf16(B0, q_, p0, 0, 0, 0); p1 = __builtin_amdgcn_mfma_f32_32x32x16_bf16(B1, q_, p1, 0, 0, 0); } while (0)
#define SEG_BEGIN(s) do { const int s_ = (s); if (!(s_ & 1) && s_ >= 2) { const int t_ = s_ >> 1; if (t_ + 1 < NT) SLOADK(t_ + 1); if (t_ < NT) SLOADV(t_); } } while (0)
#define SEG_END(s) do { if ((s) & 1) { asm volatile("s_waitcnt vmcnt(0)" ::: "memory"); SBAR(); __builtin_amdgcn_s_barrier(); asm volatile("" ::: "memory"); } SBAR(); } while (0)
#define SM_SEG() do { partialSM(p0, p1, m_reg, mn, al); finishSM(p0, p1, al, l_reg, pa0, pa1, pa2, pa3); \
      if (__any(al < 1.f)) { if (hi == 0) al_l[r32] = al; asm volatile("s_waitcnt lgkmcnt(0)" ::: "memory"); \
        _Pragma("unroll") for (int d = 0; d < 4; ++d) _Pragma("unroll") for (int r = 0; r < 16; ++r) { const float a_ = al_l[crow(r, hi)]; o[d][r] *= a_; o2[d][r] *= a_; } } } while (0)
#define M_SEG(DOPV, DOQK, JPV, JQK) do { \
      const int vb = vb0 + ((JPV) & 1) * 2 * (int)SHM_V, kc = kb0 + ((JQK) & 1) * (int)SHM_K; (void)vb; (void)kc; \
      bf16x8 a0, a1, aq, b0, b1, bq, c0, c1, cq; \
      SBAR(); \
      if (DOPV) { s16x4 FA[8], FB[8]; \
        TRG(FA, 0); \
        TRG(FB, 1); LGKM(8); PVG(o[0], FA); \
        TRG(FA, 2); LGKM(8); PVG(o[1], FB); \
        TRG(FB, 3); LGKM(8); PVG(o[2], FA); \
        TRG(FA, 4); LGKM(8); PVG(o[3], FB); \
        TRG(FB, 5); LGKM(8); PVG(o2[0], FA); \
        TRG(FA, 6); LGKM(8); PVG(o2[1], FB); \
        TRG(FB, 7); LGKM(8); PVG(o2[2], FA); \
        LGKM(0); PVG(o2[3], FB); } \
      if (DOQK) { p0 = f32x16{}; p1 = f32x16{}; \
        KR(0, a0, a1, aq); KR(1, b0, b1, bq); KR(2, c0, c1, cq); LGKM(4); QKS(0, a0, a1, aq); \
        KR(3, a0, a1, aq); LGKM(4); QKS(1, b0, b1, bq); \
        KR(4, b0, b1, bq); LGKM(5); QKS(2, c0, c1, cq); \
        KR(5, c0, c1, cq); LGKM(6); QKS(3, a0, a1, aq); \
        KR(6, a0, a1, aq); LGKM(6); QKS(4, b0, b1, bq); \
        KR(7, b0, b1, bq); LGKM(6); QKS(5, c0, c1, cq); \
        LGKM(3); QKS(6, a0, a1, aq); \
        LGKM(0); QKS(7, b0, b1, bq); } } while (0)
  if (!gB) {
    f32x16 p0, p1; bf16x8 pa0, pa1, pa2, pa3; float mn, al;
    M_SEG(0, 1, 0, 0); SEG_END(0);
#pragma unroll 1
    for (int t = 0; t < NT - 1; ++t) {
      SM_SEG(); SEG_END(2 * t + 1);
      SEG_BEGIN(2 * t + 2); M_SEG(1, 1, t, t + 1); SEG_END(2 * t + 2);
    }
    SM_SEG(); SEG_END(2 * NT - 1);
    M_SEG(1, 0, NT - 1, 0); SEG_END(2 * NT);
    SEG_END(2 * NT + 1);
  } else {
    f32x16 p0, p1; bf16x8 pa0, pa1, pa2, pa3; float mn, al;
    SEG_END(0);
    M_SEG(0, 1, 0, 0); SEG_END(1);
    SEG_BEGIN(2); SM_SEG(); SEG_END(2);
#pragma unroll 1
    for (int t = 1; t < NT; ++t) {
      M_SEG(1, 1, t - 1, t); SEG_END(2 * t + 1);
      SEG_BEGIN(2 * t + 2); SM_SEG(); SEG_END(2 * t + 2);
    }
    M_SEG(1, 0, NT - 1, 0); SEG_END(2 * NT + 1);
  }
  if (hi == 0) li_l[r32] = l_reg; asm volatile("s_waitcnt lgkmcnt(0)" ::: "memory");
#pragma unroll
  for (int r = 0; r < 16; ++r) { const float rl = __builtin_amdgcn_rcpf(li_l[crow(r, hi)]);
#pragma unroll
    for (int d0 = 0; d0 < 4; ++d0) { o[d0][r] *= rl; o2[d0][r] *= rl; } }
#undef SEG_BEGIN
#undef SEG_END
#undef SM_SEG
#undef M_SEG
#undef TILEPTR
#undef SLOADK
#undef SLOADV
#undef PKF
#undef TRG
#undef PVG
#undef KR
#undef QKS
}

__device__ __forceinline__ void attn_run(const Run& R, char* lds, float* wsf_all, const __attribute__((address_space(3))) float* biasS, f32x16 (&o)[4], int tid) {
  typedef __attribute__((address_space(3))) unsigned lds_u32;
  const int wid = __builtin_amdgcn_readfirstlane(tid >> 6), lane = tid & 63, r32 = lane & 31, hi = lane >> 5;
  const int gB = wid >> 2;
  u16* K_lds = (u16*)lds; u16* V_lds = (u16*)(lds + 2 * SHM_K);
  float* wsf = wsf_all + wid * 64; float* li_l = wsf; float* al_l = wsf + 32;
  float m_reg = -1e30f, l_reg = 0; bf16x8 qr[8];
#pragma unroll
  for (int d = 0; d < 4; ++d) o[d] = f32x16{};
  int krow[2], kcol[2], vrow[2], vcol[2];
#pragma unroll
  for (int i = 0; i < 2; ++i) { const int b = i * 8192 + wid * 1024 + lane * 16;
    krow[i] = b >> 8; kcol[i] = ((b & 255) ^ ((krow[i] & 7) << 4)) >> 1;
    const int sub = b >> 9, kk = (sub >> 2) * 8 + ((b & 511) >> 6); vcol[i] = (sub & 3) * 32 + ((b & 63) >> 1); vrow[i] = (kk & ~0xC) | ((kk & 4) << 1) | ((kk & 8) >> 1); }
  const int vb0 = (int)(uintptr_t)V_lds + v_rd_base(lane);
  const int kb0 = (int)(uintptr_t)K_lds + r32 * 256, kxr = (r32 & 7) << 4;
  const int na_rq = R.rq0 + (wid >> 1), na_cq = 32 * (wid & 1) + r32;
  int w0n = na_rq - 4; w0n = w0n < 0 ? 0 : (w0n > 24 ? 24 : w0n);
  const int NT = R.NT, nt0 = R.nt0, naf = R.na, rlo = R.rlo;
#define LIVE(j) (!(naf && (j) >= nt0) || ((rlo + ((j) - nt0)) >= w0n && (rlo + ((j) - nt0)) < w0n + 8))
#define TILEPTR(jt) const int jt_ = (jt); const u16* kp_; const u16* vp_; int ld_; \
    if (jt_ < R.nt0) { ld_ = R.ld0; kp_ = R.K0 + (long)jt_ * 64 * ld_; vp_ = R.V0 + (long)jt_ * 64 * ld_; } \
    else { ld_ = R.ld1; kp_ = R.K1 + (long)(jt_ - R.nt0) * 64 * ld_; vp_ = R.V1 + (long)(jt_ - R.nt0) * 64 * ld_; }
#define SLOADK(jt) do { TILEPTR(jt) (void)vp_; _Pragma("unroll") for (int i_ = 0; i_ < 2; ++i_) \
      __builtin_amdgcn_global_load_lds((const unsigned*)(kp_ + (krow[i_] * ld_ + kcol[i_])), (lds_u32*)((char*)K_lds + (jt_ & 1) * SHM_K + i_ * 8192 + wid * 1024), 16, 0, 0); } while (0)
#define SLOADV(jt) do { TILEPTR(jt) (void)kp_; _Pragma("unroll") for (int i_ = 0; i_ < 2; ++i_) \
      __builtin_amdgcn_global_load_lds((const unsigned*)(vp_ + (vrow[i_] * ld_ + vcol[i_])), (lds_u32*)((char*)V_lds + (jt_ & 1) * SHM_V + i_ * 8192 + wid * 1024), 16, 0, 0); } while (0)
  __syncthreads();
  { const u16* Qw = R.Q + (long)(wid * QBLK + r32) * R.ldq + hi * 8;
#pragma unroll
    for (int d0 = 0; d0 < 8; ++d0) qr[d0] = ld8(Qw + d0 * 16); }
  SLOADK(0); SLOADV(0); if (NT > 1) SLOADK(1);
  asm volatile("s_waitcnt vmcnt(0) lgkmcnt(0)" ::: "memory"); __syncthreads();
#define PKF(L, H) (bf16x8){L[0], L[1], L[2], L[3], H[0], H[1], H[2], H[3]}
#define TRG(F, G) do { F[0] = tr_read<voff2(G, 0, 0)>(vb); F[1] = tr_read<voff2(G, 0, 1)>(vb); F[2] = tr_read<voff2(G, 1, 0)>(vb); F[3] = tr_read<voff2(G, 1, 1)>(vb); \
      F[4] = tr_read<voff2(G, 2, 0)>(vb); F[5] = tr_read<voff2(G, 2, 1)>(vb); F[6] = tr_read<voff2(G, 3, 0)>(vb); F[7] = tr_read<voff2(G, 3, 1)>(vb); } while (0)
#define PVG(ACC, F) do { ACC = __builtin_amdgcn_mfma_f32_32x32x16_bf16(pa0, PKF(F[0], F[1]), ACC, 0, 0, 0); ACC = __builtin_amdgcn_mfma_f32_32x32x16_bf16(pa1, PKF(F[2], F[3]), ACC, 0, 0, 0); \
      ACC = __builtin_amdgcn_mfma_f32_32x32x16_bf16(pa2, PKF(F[4], F[5]), ACC, 0, 0, 0); ACC = __builtin_amdgcn_mfma_f32_32x32x16_bf16(pa3, PKF(F[6], F[7]), ACC, 0, 0, 0); } while (0)
#define KR(D0, B0, B1) do { const int ka_ = kc + (((((D0) & 3) * 32) + hi * 16) ^ kxr); B0 = rd128<((D0) >> 2) * 128>(ka_); B1 = rd128<((D0) >> 2) * 128 + 8192>(ka_); } while (0)
#define QKS(D0, B0, B1) do { p0 = __builtin_amdgcn_mfma_f32_32x32x16_bf16(B0, qr[D0], p0, 0, 0, 0); p1 = __builtin_amdgcn_mfma_f32_32x32x16_bf16(B1, qr[D0], p1, 0, 0, 0); } while (0)
#define SEG_BEGIN(s) do { const int s_ = (s); if (!(s_ & 1) && s_ >= 2) { const int t_ = s_ >> 1; if (t_ + 1 < NT) SLOADK(t_ + 1); if (t_ < NT) SLOADV(t_); } } while (0)
#define SEG_END(s) do { if ((s) & 1) { asm volatile("s_waitcnt vmcnt(0)" ::: "memory"); SBAR(); __builtin_amdgcn_s_barrier(); asm volatile("" ::: "memory"); } SBAR(); } while (0)
#define SM_SEG(J) do { const int j_ = (J); if (LIVE(j_)) { \
      if (naf && j_ >= nt0) na_apply(p0, p1, rlo + (j_ - nt0), na_rq, na_cq, hi, biasS); \
      partialSM(p0, p1, m_reg, mn, al); finishSM(p0, p1, al, l_reg, pa0, pa1, pa2, pa3); \
      if (__any(al < 1.f)) { if (hi == 0) al_l[r32] = al; asm volatile("s_waitcnt lgkmcnt(0)" ::: "memory"); \
        _Pragma("unroll") for (int d = 0; d < 4; ++d) _Pragma("unroll") for (int r = 0; r < 16; ++r) o[d][r] *= al_l[crow(r, hi)]; } } } while (0)
#define M_SEG(DOPV, DOQK, JPV, JQK) do { \
      const int vb = vb0 + ((JPV) & 1) * (int)SHM_V, kc = kb0 + ((JQK) & 1) * (int)SHM_K; (void)vb; (void)kc; \
      SBAR(); \
      if (DOPV && LIVE(JPV)) { s16x4 FA[8], FB[8]; \
        TRG(FA, 0); \
        TRG(FB, 1); LGKM(8); PVG(o[0], FA); \
        TRG(FA, 2); LGKM(8); PVG(o[1], FB); \
        TRG(FB, 3); LGKM(8); PVG(o[2], FA); \
        LGKM(0); PVG(o[3], FB); } \
      if (DOQK && LIVE(JQK)) { bf16x8 a0, a1, b0, b1, c0, c1; p0 = f32x16{}; p1 = f32x16{}; \
        KR(0, a0, a1); KR(1, b0, b1); KR(2, c0, c1); LGKM(4); QKS(0, a0, a1); \
        KR(3, a0, a1); LGKM(4); QKS(1, b0, b1); \
        KR(4, b0, b1); LGKM(4); QKS(2, c0, c1); \
        KR(5, c0, c1); LGKM(4); QKS(3, a0, a1); \
        KR(6, a0, a1); LGKM(4); QKS(4, b0, b1); \
        KR(7, b0, b1); LGKM(4); QKS(5, c0, c1); \
        LGKM(2); QKS(6, a0, a1); \
        LGKM(0); QKS(7, b0, b1); } } while (0)
  if (!gB) {
    f32x16 p0 = {}, p1 = {}; bf16x8 pa0 = {}, pa1 = {}, pa2 = {}, pa3 = {}; float mn, al;
    M_SEG(0, 1, 0, 0); SEG_END(0);
#pragma unroll 1
    for (int t = 0; t < NT - 1; ++t) {
      SM_SEG(t); SEG_END(2 * t + 1);
      SEG_BEGIN(2 * t + 2); M_SEG(1, 1, t, t + 1); SEG_END(2 * t + 2);
    }
    SM_SEG(NT - 1); SEG_END(2 * NT - 1);
    M_SEG(1, 0, NT - 1, 0); SEG_END(2 * NT);
    SEG_END(2 * NT + 1);
  } else {
    f32x16 p0 = {}, p1 = {}; bf16x8 pa0 = {}, pa1 = {}, pa2 = {}, pa3 = {}; float mn, al;
    SEG_END(0);
    M_SEG(0, 1, 0, 0); SEG_END(1);
    SEG_BEGIN(2); SM_SEG(0); SEG_END(2);
#pragma unroll 1
    for (int t = 1; t < NT; ++t) {
      M_SEG(1, 1, t - 1, t); SEG_END(2 * t + 1);
      SEG_BEGIN(2 * t + 2); SM_SEG(t); SEG_END(2 * t + 2);
    }
    M_SEG(1, 0, NT - 1, 0); SEG_END(2 * NT + 1);
  }
  if (hi == 0) li_l[r32] = l_reg; asm volatile("s_waitcnt lgkmcnt(0)" ::: "memory");
#pragma unroll
  for (int r = 0; r < 16; ++r) { const float rl = __builtin_amdgcn_rcpf(li_l[crow(r, hi)]);
#pragma unroll
    for (int d0 = 0; d0 < 4; ++d0) o[d0][r] *= rl; }
#undef LIVE
#undef SEG_BEGIN
#undef SEG_END
#undef SM_SEG
#undef M_SEG
#undef TILEPTR
#undef SLOADK
#undef SLOADV
#undef PKF
#undef TRG
#undef PVG
#undef KR
#undef QKS
}

__device__ __forceinline__ void tile_put(const f32x16 (&o)[4], float* T, int lane) {
  const int r32 = lane & 31, hi = lane >> 5;
  float* Tw = T + 4 * hi * 128 + r32;
#pragma unroll
  for (int r = 0; r < 16; ++r)
#pragma unroll
    for (int d0 = 0; d0 < 4; ++d0) Tw[((r & 3) + 8 * (r >> 2)) * 128 + 32 * d0] = hi ? o[d0 ^ 1][r] : o[d0][r];
}
__device__ __forceinline__ void tile_emit(float* T, int lane, const u16* gate, long ldg, u16* y, long ldy, const float* sub, const float* rsc) {
  const int r32 = lane & 31, hi = lane >> 5;
  const int c = 4 * r32;
  float s0 = 1.f, s1 = 1.f, s2 = 1.f, s3 = 1.f;
  if (sub) { s0 = sub[c]; s1 = sub[c + 1]; s2 = sub[c + 2]; s3 = sub[c + 3]; }
  typedef unsigned u32x2_ __attribute__((ext_vector_type(2)));
  u32x2_ gv[16];
#pragma unroll
  for (int it = 0; it < 16; ++it) gv[it] = *(const u32x2_*)(gate + (long)(2 * it + hi) * ldg + c);
  __builtin_amdgcn_sched_barrier(0);
  asm volatile("s_waitcnt lgkmcnt(0)" ::: "memory");
#define SILU_(x) ((x) * __builtin_amdgcn_rcpf(1.f + __builtin_amdgcn_exp2f(-1.4426950408889634f * (x))))
#pragma unroll
  for (int it = 0; it < 16; ++it) { const int row = 2 * it + hi;
    const float* tp = T + row * 128 + (c ^ (((row >> 2) & 1) << 5));
    const float rr = rsc ? rsc[row] : 1.f;
    const float v0 = tp[0] * rr, v1 = tp[1] * rr, v2 = tp[2] * rr, v3 = tp[3] * rr;
    const unsigned g01 = gv[it].x, g23 = gv[it].y;
    const float a0 = __uint_as_float(g01 << 16), a1 = __uint_as_float(g01 & 0xffff0000u), a2 = __uint_as_float(g23 << 16), a3 = __uint_as_float(g23 & 0xffff0000u);
    u32x2_ w; w.x = cvtpk(v0 * s0 * SILU_(a0), v1 * s1 * SILU_(a1)); w.y = cvtpk(v2 * s2 * SILU_(a2), v3 * s3 * SILU_(a3));
    *(u32x2_*)(y + (long)row * ldy + c) = w;
  }
#undef SILU_
  asm volatile("s_waitcnt lgkmcnt(0)" ::: "memory");
}
__device__ __forceinline__ void store_tile(const f32x16 (&o)[4], float* T, int lane, const u16* gate, long ldg, u16* y, long ldy, const float* sub) {
  tile_put(o, T, lane); tile_emit(T, lane, gate, ldg, y, ldy, sub, nullptr);
}
}
namespace ret {
typedef unsigned short u16;
using bf16x8 = __attribute__((ext_vector_type(8))) short;
using f32x4 = __attribute__((ext_vector_type(4))) float;
using u32x2 = __attribute__((ext_vector_type(2))) unsigned;
using u32x4 = __attribute__((ext_vector_type(4))) unsigned;
using s16x4_t = __attribute__((ext_vector_type(4))) short;
#define RSWZ(row, cb) ((row) * 256 + ((cb) ^ (((row) & 15) << 4)))
__device__ __forceinline__ unsigned cvtpk(float lo, float hi) { unsigned r; asm volatile("v_cvt_pk_bf16_f32 %0, %1, %2" : "=v"(r) : "v"(lo), "v"(hi)); return r; }
__device__ __forceinline__ float bf_lo(unsigned w) { return __uint_as_float(w << 16); }
__device__ __forceinline__ float bf_hi(unsigned w) { return __uint_as_float(w & 0xffff0000u); }
__device__ __forceinline__ float silu(float x) { return x * __builtin_amdgcn_rcpf(1.f + __builtin_amdgcn_exp2f(-1.4426950408889634f * x)); }

#define ROFF(row, ch) (256 * (row) + 16 * ((ch) ^ ((((row) & 3) << 2) | (((row) >> 2) & 3))))
struct TrOff { int t0[8], t1[8]; };
__device__ __forceinline__ int troff(int lane, int c, int t) {
  const int g = lane >> 4, q4 = (lane & 15) >> 2, pp = lane & 3;
  const int row = 8 * g + 4 * t + q4;
  return ROFF(row, 2 * c + (pp >> 1)) + 8 * (pp & 1);
}
__device__ __forceinline__ s16x4_t tr16(int addr) { s16x4_t r; asm volatile("ds_read_b64_tr_b16 %0, %1" : "=&v"(r) : "v"(addr) : "memory"); return r; }
template <int OFF> __device__ __forceinline__ s16x4_t tr16o(int addr) { s16x4_t r; asm volatile("ds_read_b64_tr_b16 %0, %1 offset:%2" : "=&v"(r) : "v"(addr), "i"(OFF) : "memory"); return r; }
#define FRAG8(L, H) (bf16x8){L[0], L[1], L[2], L[3], H[0], H[1], H[2], H[3]}
struct TrFrag { s16x4_t l[4], h[4]; };
template <int BASE> __device__ __forceinline__ TrFrag tr_frag(int a0, int a1) {
  TrFrag f;
  f.l[0] = tr16o<BASE>(a0); f.h[0] = tr16o<BASE>(a1); f.l[1] = tr16o<BASE + 8192>(a0); f.h[1] = tr16o<BASE + 8192>(a1);
  f.l[2] = tr16o<BASE + 16384>(a0); f.h[2] = tr16o<BASE + 16384>(a1); f.l[3] = tr16o<BASE + 24576>(a0); f.h[3] = tr16o<BASE + 24576>(a1);
  return f;
}
__device__ __forceinline__ void mm_rr(f32x4 (&acc)[8], const char* XA, const char* XB, int w, int lane) {
  const int r = lane & 15, q = lane >> 4;
  int bo[4];
#pragma unroll
  for (int ks = 0; ks < 4; ++ks) bo[ks] = ROFF(r, 4 * ks + q);
  bf16x8 a[4], bc[4], bn[4];
#pragma unroll
  for (int ks = 0; ks < 4; ++ks) { a[ks] = *(const bf16x8*)(XA + w * 4096 + bo[ks]); bc[ks] = *(const bf16x8*)(XB + bo[ks]); }
#pragma unroll
  for (int n = 0; n < 8; ++n) {
    if (n < 7) {
#pragma unroll
      for (int ks = 0; ks < 4; ++ks) bn[ks] = *(const bf16x8*)(XB + bo[ks] + (n + 1) * 4096); }
#pragma unroll
    for (int ks = 0; ks < 4; ++ks) acc[n] = __builtin_amdgcn_mfma_f32_16x16x32_bf16(bc[ks], a[ks], acc[n], 0, 0, 0);
    asm volatile("" ::: "memory");
#pragma unroll
    for (int ks = 0; ks < 4; ++ks) bc[ks] = bn[ks];
  }
}
template <int BOFF> __device__ __forceinline__ void mm_rt(f32x4 (&acc)[8], const char* XA, const TrOff& tv, int w, int lane) {
  const int r = lane & 15, q = lane >> 4;
  bf16x8 a[4];
#pragma unroll
  for (int ks = 0; ks < 4; ++ks) a[ks] = *(const bf16x8*)(XA + w * 4096 + ROFF(r, 4 * ks + q));
  asm volatile("s_waitcnt lgkmcnt(0)" ::: "memory");
  TrFrag fc = tr_frag<BOFF>(tv.t0[0], tv.t1[0]);
#pragma unroll
  for (int n = 0; n < 8; ++n) {
    TrFrag fn = fc;
    if (n < 7) { fn = tr_frag<BOFF>(tv.t0[n + 1], tv.t1[n + 1]); asm volatile("s_waitcnt lgkmcnt(8)" ::: "memory"); }
    else asm volatile("s_waitcnt lgkmcnt(0)" ::: "memory");
    __builtin_amdgcn_sched_barrier(0);
#pragma unroll
    for (int ks = 0; ks < 4; ++ks) acc[n] = __builtin_amdgcn_mfma_f32_16x16x32_bf16(FRAG8(fc.l[ks], fc.h[ks]), a[ks], acc[n], 0, 0, 0);
    __builtin_amdgcn_sched_barrier(0);
    fc = fn;
  }
}
template <int BOFF> __device__ __forceinline__ void mm_tt2(f32x4 (&acc1)[8], f32x4 (&acc2)[8], int ta0, int ta1, const char* XA2, const TrOff& tv, int w, int lane) {
  const int r = lane & 15, q = lane >> 4;
  bf16x8 a2[4];
#pragma unroll
  for (int ks = 0; ks < 4; ++ks) a2[ks] = *(const bf16x8*)(XA2 + w * 4096 + ROFF(r, 4 * ks + q));
  asm volatile("s_waitcnt lgkmcnt(0)" ::: "memory");
  const TrFrag fa = tr_frag<0>(ta0, ta1);
  TrFrag fc = tr_frag<BOFF>(tv.t0[0], tv.t1[0]);
#pragma unroll
  for (int n = 0; n < 8; ++n) {
    TrFrag fn = fc;
    if (n < 7) { fn = tr_frag<BOFF>(tv.t0[n + 1], tv.t1[n + 1]); asm volatile("s_waitcnt lgkmcnt(8)" ::: "memory"); }
    else asm volatile("s_waitcnt lgkmcnt(0)" ::: "memory");
    __builtin_amdgcn_sched_barrier(0);
#pragma unroll
    for (int ks = 0; ks < 4; ++ks) { const bf16x8 bf = FRAG8(fc.l[ks], fc.h[ks]);
      acc1[n] = __builtin_amdgcn_mfma_f32_16x16x32_bf16(bf, FRAG8(fa.l[ks], fa.h[ks]), acc1[n], 0, 0, 0);
      acc2[n] = __builtin_amdgcn_mfma_f32_16x16x32_bf16(bf, a2[ks], acc2[n], 0, 0, 0); }
    __builtin_amdgcn_sched_barrier(0);
    fc = fn;
  }
}
__device__ __forceinline__ void nat_load(bf16x8 (&v)[4], const u16* src, int tid) {
#pragma unroll
  for (int s = 0; s < 4; ++s) { const int p = tid + 512 * s, row = p >> 4, ch = p & 15; v[s] = *(const bf16x8*)(src + (size_t)row * 16384 + ch * 8); }
}
__device__ __forceinline__ void nat_write(char* X, const bf16x8 (&v)[4], int tid) {
#pragma unroll
  for (int s = 0; s < 4; ++s) { const int p = tid + 512 * s, row = p >> 4, ch = p & 15; *(bf16x8*)(X + ROFF(row, ch)) = v[s]; }
}
__device__ __forceinline__ void nat_write_scaled(char* X, const bf16x8 (&v)[4], int tid, float lg2, int dirb) {
#pragma unroll
  for (int s = 0; s < 4; ++s) { const int p = tid + 512 * s, row = p >> 4, ch = p & 15;
    const float kd = __builtin_amdgcn_exp2f(lg2 * (float)(dirb ? row : 127 - row));
    const u32x4 x = __builtin_bit_cast(u32x4, v[s]); u32x4 y;
#pragma unroll
    for (int k = 0; k < 4; ++k) y[k] = cvtpk(bf_lo(x[k]) * kd, bf_hi(x[k]) * kd);
    *(u32x4*)(X + ROFF(row, ch)) = y; }
}

#define RET_BAR() do { asm volatile("s_waitcnt lgkmcnt(0)" ::: "memory"); __builtin_amdgcn_s_barrier(); asm volatile("" ::: "memory"); } while (0)
__device__ __forceinline__ void ret_unit(char* lds, const u16* P, float* OD, u16* Yfin, const float* s0, float* sout, int nchunk, int h, int dir, float lg2, int tid) {
  const int w = __builtin_amdgcn_readfirstlane(tid >> 6);
  int lane = tid & 63, r = lane & 15, q = lane >> 4;
  char* X0 = lds; char* X1 = lds + 32768; char* X2 = lds + 65536; char* X3 = lds + 98304;
  int i_loc = 16 * w + r;
  f32x4 S[8];
  if (s0) { const float* sp = s0 + (size_t)i_loc * 128 + 4 * q;
#pragma unroll
    for (int n = 0; n < 8; ++n) S[n] = *(const f32x4*)(sp + 16 * n); }
  else {
#pragma unroll
    for (int n = 0; n < 8; ++n) S[n] = (f32x4){0.f, 0.f, 0.f, 0.f}; }
  bf16x8 pq[4], pk[4], pv[4];
  { const u16* Pc = P + (size_t)((dir ? nchunk - 1 : 0) * 128) * 16384;
    nat_load(pq, Pc + 8 * 1024 + h * 128, tid); nat_load(pk, Pc + 9 * 1024 + h * 128, tid); nat_load(pv, Pc + 10 * 1024 + h * 128, tid); }
  __syncthreads();
#pragma unroll
  for (int n = 0; n < 8; ++n) { u32x2 pk2_; pk2_.x = cvtpk(S[n][0], S[n][1]); pk2_.y = cvtpk(S[n][2], S[n][3]); *(u32x2*)(X3 + ROFF(i_loc, 2 * n + (q >> 1)) + 8 * (q & 1)) = pk2_; }
  const float cd = __builtin_amdgcn_exp2f(lg2 * 128.f);
  for (int cs = 0; cs < nchunk; ++cs) {
    asm volatile("" : "+v"(lane));
    r = lane & 15; q = lane >> 4; i_loc = 16 * w + r;
    const int tl = w * 64 + lane;
    const int c = dir ? nchunk - 1 - cs : cs;
    const u16* Pc = P + (size_t)(c * 128) * 16384;
    TrOff tv;
#pragma unroll
    for (int n = 0; n < 8; ++n) { tv.t0[n] = (int)(uintptr_t)X2 + troff(lane, n, 0); tv.t1[n] = (int)(uintptr_t)X2 + troff(lane, n, 1); }
    nat_write(X0, pq, tl); nat_write_scaled(X1, pk, tl, lg2, dir); nat_write(X2, pv, tl);
    RET_BAR();
    f32x4 aA[8], aO[8];
#pragma unroll
    for (int n = 0; n < 8; ++n) { aA[n] = (f32x4){0.f, 0.f, 0.f, 0.f}; aO[n] = (f32x4){0.f, 0.f, 0.f, 0.f}; }
    mm_rr(aA, X0, X1, w, lane);
    mm_rt<32768>(aO, X0, tv, w, lane);
    RET_BAR();
    { const float rf = __builtin_amdgcn_exp2f(lg2 * (float)(dir ? -i_loc : i_loc - 127));
#pragma unroll
      for (int n = 0; n < 8; ++n) { float v[4];
#pragma unroll
        for (int i = 0; i < 4; ++i) { const int j = 16 * n + 4 * q + i; const bool keep = dir ? (j >= i_loc) : (j <= i_loc); v[i] = keep ? aA[n][i] * rf : 0.f; }
        u32x2 pk2_; pk2_.x = cvtpk(v[0], v[1]); pk2_.y = cvtpk(v[2], v[3]);
        *(u32x2*)(X0 + ROFF(i_loc, 2 * n + (q >> 1)) + 8 * (q & 1)) = pk2_; } }
    { const float qdec = __builtin_amdgcn_exp2f(lg2 * (float)(dir ? 128 - i_loc : i_loc + 1));
#pragma unroll
      for (int n = 0; n < 8; ++n) { aO[n] = aO[n] * qdec; S[n] = S[n] * cd; } }
    if (cs + 1 < nchunk) { const u16* Pn = P + (size_t)((dir ? c - 1 : c + 1) * 128) * 16384;
      nat_load(pq, Pn + 8 * 1024 + h * 128, tl); nat_load(pk, Pn + 9 * 1024 + h * 128, tl); nat_load(pv, Pn + 10 * 1024 + h * 128, tl); }
    RET_BAR();
    mm_tt2<0>(S, aO, (int)(uintptr_t)X1 + troff(lane, w, 0), (int)(uintptr_t)X1 + troff(lane, w, 1), X0, tv, w, lane);
    { float* op = OD + (size_t)(c * 128 + i_loc) * 1024 + h * 128 + 4 * q;
      if (!Yfin) {
#pragma unroll
        for (int n = 0; n < 8; ++n) *(f32x4*)(op + 16 * n) = aO[n];
      } else {
        const u16* gp = Pc + (size_t)i_loc * 16384 + 11 * 1024 + h * 128 + 4 * q;
        f32x4 od[8]; u32x2 gwv[8];
#pragma unroll
        for (int n = 0; n < 8; ++n) od[n] = *(const f32x4*)(op + 16 * n);
#pragma unroll
        for (int n = 0; n < 8; ++n) gwv[n] = *(const u32x2*)(gp + 16 * n);
        float sum = 0.f;
#pragma unroll
        for (int n = 0; n < 8; ++n) { aO[n] = aO[n] + od[n]; sum += (aO[n][0] + aO[n][1]) + (aO[n][2] + aO[n][3]); }
        sum += att::swz_xor<16>(sum); sum = att::sum_xor32(sum);
        const float mean = sum * (1.f / 128.f); float vs = 0.f;
#pragma unroll
        for (int n = 0; n < 8; ++n) { const f32x4 d = aO[n] - mean; vs += (d[0] * d[0] + d[1] * d[1]) + (d[2] * d[2] + d[3] * d[3]); }
        vs += att::swz_xor<16>(vs); vs = att::sum_xor32(vs);
        const float rstd = 1.f / sqrtf(vs * (1.f / 128.f) + 1e-6f);
        u16* yp = Yfin + (size_t)(c * 128 + i_loc) * 4096 + 2048 + h * 128 + 4 * q;
#pragma unroll
        for (int n = 0; n < 8; ++n) { const u32x2 gw = gwv[n];
          const float y0 = (aO[n][0] - mean) * rstd * silu(bf_lo(gw.x)), y1 = (aO[n][1] - mean) * rstd * silu(bf_hi(gw.x));
          const float y2 = (aO[n][2] - mean) * rstd * silu(bf_lo(gw.y)), y3 = (aO[n][3] - mean) * rstd * silu(bf_hi(gw.y));
          u32x2 pk; pk.x = cvtpk(y0, y1); pk.y = cvtpk(y2, y3);
          *(u32x2*)(yp + 16 * n) = pk; }
      } }
    RET_BAR();
#pragma unroll
    for (int n = 0; n < 8; ++n) { u32x2 pk2_; pk2_.x = cvtpk(S[n][0], S[n][1]); pk2_.y = cvtpk(S[n][2], S[n][3]); *(u32x2*)(X3 + ROFF(i_loc, 2 * n + (q >> 1)) + 8 * (q & 1)) = pk2_; }
  }
  if (sout) { float* sp = sout + (size_t)i_loc * 128 + 4 * q;
#pragma unroll
    for (int n = 0; n < 8; ++n) *(f32x4*)(sp + 16 * n) = S[n]; }
}

__device__ __forceinline__ void conv_unit(const u16* Pall, u16* Yall, const float* cw, int m0, int tid) {
  const int cg = tid & 127, sub = tid >> 7, c0 = cg * 8;
  float w0[8], w1[8], w2[8];
#pragma unroll
  for (int k = 0; k < 8; ++k) { w0[k] = cw[(c0 + k) * 3 + 0]; w1[k] = cw[(c0 + k) * 3 + 1]; w2[k] = cw[(c0 + k) * 3 + 2]; }
  const int t0 = m0 + sub * 16;
#define SEQPOS(m) ((m) < 4096 ? ((m) & 255) : (((m) - 4096) & 2047))
#define SEQLEN(m) ((m) < 4096 ? 256 : 2048)
  const bool hasP = SEQPOS(t0) > 0, hasN = SEQPOS(t0 + 15) < SEQLEN(t0) - 1;
#pragma unroll 1
  for (int g = 0; g < 4; ++g) {
    const int tb = t0 + 4 * g;
    u32x4 ra[6], rb[6], rbb[4], rgg[4];
#pragma unroll
    for (int k = 0; k < 6; ++k) {
      const bool ok = (k == 0) ? (g > 0 || hasP) : (k == 5) ? (g < 3 || hasN) : true;
      if (ok) { ra[k] = *(const u32x4*)(Pall + (size_t)(tb - 1 + k) * 16384 + 12 * 1024 + c0); rb[k] = *(const u32x4*)(Pall + (size_t)(tb - 1 + k) * 16384 + 14 * 1024 + c0); }
      else { ra[k] = (u32x4){0u, 0u, 0u, 0u}; rb[k] = (u32x4){0u, 0u, 0u, 0u}; }
    }
#pragma unroll
    for (int k = 0; k < 4; ++k) { rbb[k] = *(const u32x4*)(Pall + (size_t)(tb + k) * 16384 + 13 * 1024 + c0); rgg[k] = *(const u32x4*)(Pall + (size_t)(tb + k) * 16384 + 15 * 1024 + c0); }
    float u[6][8];
#pragma unroll
    for (int k = 0; k < 6; ++k) {
#pragma unroll
      for (int e = 0; e < 4; ++e) { u[k][2 * e] = bf_lo(ra[k][e]) * bf_lo(rb[k][e]); u[k][2 * e + 1] = bf_hi(ra[k][e]) * bf_hi(rb[k][e]); } }
#pragma unroll
    for (int k = 0; k < 4; ++k) {
      float y[8];
#pragma unroll
      for (int e = 0; e < 4; ++e) {
        y[2 * e] = silu(bf_lo(rgg[k][e])) * bf_lo(rbb[k][e]) * (w0[2 * e] * u[k][2 * e] + w1[2 * e] * u[k + 1][2 * e] + w2[2 * e] * u[k + 2][2 * e]);
        y[2 * e + 1] = silu(bf_hi(rgg[k][e])) * bf_hi(rbb[k][e]) * (w0[2 * e + 1] * u[k][2 * e + 1] + w1[2 * e + 1] * u[k + 1][2 * e + 1] + w2[2 * e + 1] * u[k + 2][2 * e + 1]); }
      u32x4 o; o.x = cvtpk(y[0], y[1]); o.y = cvtpk(y[2], y[3]); o.z = cvtpk(y[4], y[5]); o.w = cvtpk(y[6], y[7]);
      *(u32x4*)(Yall + (size_t)(tb + k) * 4096 + 3072 + c0) = o;
    }
  }
}
}
#ifndef PROBE_MASK
#define PROBE_MASK 0
#endif
#ifndef PROBE_RELAUNCH_LO
#define PROBE_RELAUNCH_LO -1
#define PROBE_RELAUNCH_HI -1
#endif
#ifndef PROBE_ULO
#define PROBE_ULO 0
#define PROBE_UHI 100000
#endif
#ifndef MK_N_LAUNCHES
#define MK_N_LAUNCHES 1
#endif
constexpr int NWAVES = 8;
constexpr int N_PHASES = 10;
constexpr int N_LAUNCHES = MK_N_LAUNCHES;

constexpr int DM = 4096, DIN = 16384, MP = 4096, MS = 16384, MTOT = 20480;
constexpr float LN_EPS = 1e-6f;
constexpr size_t O_NAK = 83886080ull, O_NAV = 92274688ull, O_DFK = 100663296ull, O_DFV = 109051904ull, O_ST = 117440512ull;
constexpr size_t MiB = 1ull << 20;
constexpr size_t WS_CTL = 0, CTL_ZERO_BYTES = 1 * MiB;
constexpr size_t WS_MOD = 1 * MiB;
constexpr size_t WS_ROPE = 2 * MiB;
constexpr size_t WS_MISC = 3 * MiB;
constexpr size_t WS_WIN = 4 * MiB;
constexpr size_t WS_WOUT = 260 * MiB;
constexpr size_t WS_CACHE = 324 * MiB;
constexpr size_t WS_H = 388 * MiB;
constexpr size_t WS_P = 548 * MiB;
constexpr size_t WS_Y = 1188 * MiB;
constexpr size_t WS_OF = 1348 * MiB;
constexpr size_t WS_DP = 1428 * MiB;
constexpr size_t WS_OF2 = 1492 * MiB;
constexpr size_t WS_X1 = 1572 * MiB;
constexpr size_t WS_DP4 = 1892 * MiB;
constexpr size_t WS_END = 2020 * MiB;
constexpr int CW_Q0 = 64, CW_QM0 = 128, CW_QM1 = 192, CW_BAR = 4096;
constexpr int RING_BYTES = 131072, BIAS_OFF = 131072, WSF_OFF = BIAS_OFF + 2048, MISC_OFF = WSF_OFF + 2048, LDS_BYTES = 147456;
static_assert(att::SHM_ATTN <= (size_t)BIAS_OFF && 2 * att::SHM_K + 4 * att::SHM_V + 8 * 4096 <= (size_t)BIAS_OFF, "attention LDS");

#define GAS __attribute__((address_space(1)))
#define LAS __attribute__((address_space(3)))
typedef unsigned short bf16;
typedef unsigned v4u __attribute__((ext_vector_type(4)));
typedef unsigned v2u __attribute__((ext_vector_type(2)));
typedef float f32x4 __attribute__((ext_vector_type(4)));
typedef short bf16x8 __attribute__((ext_vector_type(8)));
typedef GAS unsigned gu32;
#define RLX_AGENT __ATOMIC_RELAXED, __HIP_MEMORY_SCOPE_AGENT
#define LDS_WAIT() asm volatile("s_waitcnt lgkmcnt(0)" ::: "memory")
#define VM_WAIT() asm volatile("s_waitcnt vmcnt(0)" ::: "memory")
__device__ __forceinline__ unsigned pk2(float lo, float hi) { unsigned r; asm volatile("v_cvt_pk_bf16_f32 %0, %1, %2" : "=v"(r) : "v"(lo), "v"(hi)); return r; }
__device__ __forceinline__ float bflo(unsigned w) { return __uint_as_float(w << 16); }
__device__ __forceinline__ float bfhi(unsigned w) { return __uint_as_float(w & 0xffff0000u); }
__device__ __forceinline__ float siluf(float x) { return x * __builtin_amdgcn_rcpf(1.f + __builtin_amdgcn_exp2f(-1.4426950408889634f * x)); }

__device__ __forceinline__ int lane_id() { int r; asm volatile("v_mbcnt_lo_u32_b32 %0, -1, 0\n\tv_mbcnt_hi_u32_b32 %0, -1, %0" : "=v"(r)); return r; }
#define TIDNOW(wk) ((wk) * 64 + lane_id())
#define XB_TMO      128
#define XB_XCNT(j)  (256  + 64 * (j))
#define XB_XSUB(j)  (1280 + 64 * (j))
#define XB_XGEN(j)  (2304 + 64 * (j))
#define XB_TOP      3328
#define XB_TOPGEN   3392
#define XCD_BAR_WORDS 3456
#define XB_SPIN_CAP (1u << 18)
__device__ __forceinline__ unsigned xb_ld(unsigned* p)              { return __hip_atomic_load(p, __ATOMIC_RELAXED, __HIP_MEMORY_SCOPE_AGENT); }
__device__ __forceinline__ unsigned xb_add(unsigned* p, unsigned v) { return __hip_atomic_fetch_add(p, v, __ATOMIC_RELAXED, __HIP_MEMORY_SCOPE_AGENT); }
__device__ __forceinline__ unsigned xb_xcc_id() { return (unsigned)__builtin_amdgcn_s_getreg((3 << 11) | 20) & 0xFu; }
#define XB_SPIN(cond, bar) do { unsigned _sp = 0; while (cond) { __builtin_amdgcn_s_sleep(1); \
    if ((++_sp & 255u) == 0u) { if (xb_ld(&(bar)[XB_TMO])) break; if (_sp > XB_SPIN_CAP) { atomicAdd(&(bar)[XB_TMO], 1u); break; } } } } while (0)
struct XcdBarrier { unsigned* bar; unsigned x; volatile LAS unsigned* st; int wk; };
__device__ __forceinline__ XcdBarrier xcd_barrier_post(unsigned* bar, volatile LAS unsigned* st) {
    XcdBarrier b; b.bar = bar; b.x = xb_xcc_id(); b.st = st;
    if (threadIdx.x == 0) (void)xb_add(&bar[XB_XCNT(b.x)], 1u);
    return b;
}
__device__ __forceinline__ void xcd_barrier_complete(unsigned* bar, unsigned x, unsigned& nloc, unsigned& nx) {
    const unsigned G = gridDim.x * gridDim.y * gridDim.z;
    unsigned sum, cnt, mine, sp = 0u;
    for (;;) {
        sum = 0u; cnt = 0u; mine = 0u;
#pragma unroll
        for (unsigned j = 0; j < 16; ++j) { const unsigned c = xb_ld(&bar[XB_XCNT(j)]); sum += c; cnt += (c > 0u) ? 1u : 0u; mine = (j == x) ? c : mine; }
        if (sum == G) break;
        __builtin_amdgcn_s_sleep(1);
        if ((++sp & 255u) == 0u) { if (xb_ld(&bar[XB_TMO])) break; if (sp > XB_SPIN_CAP) { atomicAdd(&bar[XB_TMO], 1u); break; } }
    }
    nloc = mine > 0u ? mine : 1u; nx = cnt > 0u ? cnt : 1u;
}
__device__ __forceinline__ void xcd_barrier(const XcdBarrier& b) {
    asm volatile("s_waitcnt vmcnt(0)" ::: "memory");
    __syncthreads();
    if (b.wk == 0 && lane_id() == 0) {
        unsigned bx = b.x; asm volatile("" : "+v"(bx)); bx = __builtin_amdgcn_readfirstlane(bx);
        unsigned* bar = b.bar;
        __builtin_amdgcn_s_waitcnt(0);
        unsigned nloc = b.st[0], nx = b.st[1];
        if (nloc == 0u) { xcd_barrier_complete(bar, bx, nloc, nx); b.st[0] = nloc; b.st[1] = nx; }
        const unsigned old = xb_add(&bar[XB_XSUB(bx)], 1u);
        const unsigned gen = old / nloc;
        if (old + 1u == (gen + 1u) * nloc) {
            __builtin_amdgcn_fence(__ATOMIC_RELEASE, "agent");
            asm volatile("s_waitcnt vmcnt(0)" ::: "memory");
            const unsigned og = xb_add(&bar[XB_TOP], 1u);
            const unsigned tg = og / nx;
            if (og + 1u == (tg + 1u) * nx) xb_add(&bar[XB_TOPGEN], 1u);
            else XB_SPIN(xb_ld(&bar[XB_TOPGEN]) == tg, bar);
            __builtin_amdgcn_fence(__ATOMIC_ACQUIRE, "agent");
            xb_add(&bar[XB_XGEN(bx)], 1u);
            asm volatile("s_waitcnt vmcnt(0)" ::: "memory");
        } else {
            XB_SPIN(xb_ld(&bar[XB_XGEN(bx)]) == gen, bar);
            __builtin_amdgcn_fence(__ATOMIC_ACQUIRE, "agent");
            asm volatile("s_waitcnt vmcnt(0)" ::: "memory");
        }
    }
    __syncthreads();
}

__device__ __forceinline__ float wave_sum(float v) {
    v += att::swz_xor<1>(v); v += att::swz_xor<2>(v); v += att::swz_xor<4>(v); v += att::swz_xor<8>(v); v += att::swz_xor<16>(v);
    return att::sum_xor32(v);
}
__device__ __forceinline__ int next_unit(gu32* ctr, volatile LAS unsigned* slot, int G, int wk) {
    asm volatile("s_waitcnt lgkmcnt(0)" ::: "memory"); __builtin_amdgcn_s_barrier(); asm volatile("" ::: "memory");
    if (wk == 0 && lane_id() == 0) *slot = (unsigned)G + __hip_atomic_fetch_add(ctr, 1u, RLX_AGENT);
    asm volatile("s_waitcnt lgkmcnt(0)" ::: "memory"); __builtin_amdgcn_s_barrier(); asm volatile("" ::: "memory");
    return __builtin_amdgcn_readfirstlane((int)*slot);
}

__device__ __forceinline__ void p0_transpose_item(const float* W, int K, int N, bf16* WT, LAS float* scr, int item, int lane) {
    const int nblk = N / 32, kb = item / nblk, nb = item % nblk, k0 = 64 * kb, n0 = 32 * nb;
    const float sc = (N == 16384 && n0 >= 9216 && n0 < 10240) ? 0.088388347648318440f : 1.f;
    float wv[32];
#pragma unroll
    for (int i = 0; i < 32; ++i) wv[i] = __builtin_nontemporal_load(&W[(size_t)(k0 + 2 * i + (lane >> 5)) * N + n0 + (lane & 31)]);
#pragma unroll
    for (int i = 0; i < 32; ++i) { const int kk = 2 * i + (lane >> 5); scr[kk * 33 + (lane & 31)] = wv[i] * sc; }
    LDS_WAIT(); asm volatile("" ::: "memory");
    const int c = lane & 7;
#pragma unroll
    for (int j = 0; j < 4; ++j) { const int n = (lane >> 3) + 8 * j; const LAS float* s = scr + (8 * c) * 33 + n;
        v4u o; o.x = pk2(s[0 * 33], s[1 * 33]); o.y = pk2(s[2 * 33], s[3 * 33]); o.z = pk2(s[4 * 33], s[5 * 33]); o.w = pk2(s[6 * 33], s[7 * 33]);
        *(GAS v4u*)(WT + (size_t)(n0 + n) * K + k0 + 8 * c) = o; }
    LDS_WAIT(); asm volatile("" ::: "memory");
}

struct Args { const float* in[20]; float* out; unsigned char* ws; int ph_lo, ph_hi; };
struct DArgs { GAS const float* in[20]; GAS float* out; GAS unsigned char* ws; };

constexpr int P0_GEMV = 96, P0_MISC = 1, P0_TR = 640, P0_CV = 1024, P0_UNITS = P0_GEMV + P0_MISC + P0_TR + P0_CV;
constexpr int DEF_GEMV = 96, DEF_TR = 640, DEF_UNITS = DEF_GEMV + DEF_TR;
__device__ __forceinline__ void p0_gemv_unit(const DArgs& a, LAS unsigned char* lds, int uidx, const int tid) {
    const int l = uidx / 96, cb = uidx % 96, col0 = cb * 128, tx = tid & 31, kg = tid >> 5;
    const float* c = ((const float*)a.in[7]); const float* cctx = ((const float*)a.in[8]); const float* wada = ((const float*)a.in[9]) + (size_t)l * 4096 * 12288; const float* bada = ((const float*)a.in[10]) + (size_t)l * 12288;
    float* mod = (float*)(((unsigned char*)a.ws) + WS_MOD) + (size_t)l * 9 * 12288;
    LAS float* sc = (LAS float*)lds;
    float acc[9][4];
#pragma unroll
    for (int v = 0; v < 9; ++v)
#pragma unroll
        for (int j = 0; j < 4; ++j) acc[v][j] = 0.f;
    for (int half = 0; half < 2; ++half) {
        __syncthreads();
        for (int idx = tid; idx < 2048 * 9; idx += 512) { const int k = idx / 9, v = idx - 9 * k; const float x = (v < 8) ? c[v * 4096 + half * 2048 + k] : cctx[half * 2048 + k]; sc[k * 12 + v] = siluf(x); }
        __syncthreads();
        const float* wp = wada + (size_t)(half * 2048 + kg * 128) * 12288 + col0 + tx * 4;
#pragma unroll 1
        for (int kk0 = 0; kk0 < 128; kk0 += 16) {
            f32x4 wv[16];
#pragma unroll
            for (int i = 0; i < 16; ++i) wv[i] = __builtin_nontemporal_load((const f32x4*)(wp + (size_t)(kk0 + i) * 12288));
            __builtin_amdgcn_sched_barrier(0);
#pragma unroll
            for (int i = 0; i < 16; ++i) { const f32x4 w = wv[i];
                const LAS float* sp = sc + (kg * 128 + kk0 + i) * 12;
                const f32x4 s0 = *(const LAS f32x4*)sp, s1 = *(const LAS f32x4*)(sp + 4); const float s8 = sp[8];
#pragma unroll
                for (int j = 0; j < 4; ++j) { acc[0][j] += s0[0] * w[j]; acc[1][j] += s0[1] * w[j]; acc[2][j] += s0[2] * w[j]; acc[3][j] += s0[3] * w[j];
                    acc[4][j] += s1[0] * w[j]; acc[5][j] += s1[1] * w[j]; acc[6][j] += s1[2] * w[j]; acc[7][j] += s1[3] * w[j]; acc[8][j] += s8 * w[j]; } }
        }
    }
    __syncthreads();
    LAS float* red = (LAS float*)lds;
#pragma unroll
    for (int v = 0; v < 9; ++v)
#pragma unroll
        for (int j = 0; j < 4; ++j) red[(kg * 9 + v) * 128 + tx * 4 + j] = acc[v][j];
    __syncthreads();
    for (int o = tid; o < 9 * 128; o += 512) { const int v = o >> 7, cc = o & 127; float s = bada[col0 + cc];
#pragma unroll
        for (int g = 0; g < 16; ++g) s += red[(g * 9 + v) * 128 + cc];
        mod[(size_t)v * 12288 + col0 + cc] = s; }
}
__device__ __forceinline__ void p0_misc_unit(const DArgs& a, const int tid) {
    float* rope = (float*)(((unsigned char*)a.ws) + WS_ROPE);
    for (int e = tid; e < 64 * 32; e += 512) { const int pos = e >> 5, f = e & 31;
        const float inv = __builtin_amdgcn_exp2f(-(float)f * (13.287712379549449f / 32.f));
        const float ang = (float)pos * inv; const float rev = ang * 0.15915494309189535f;
        const float fr = rev - floorf(rev);
        rope[2 * e] = __builtin_amdgcn_cosf(fr); rope[2 * e + 1] = __builtin_amdgcn_sinf(fr); }
    if (tid < 2) { const float* lf = ((const float*)a.in[16]) + (size_t)tid * 4 * 128; float s1 = 0.f, s2 = 0.f;
        for (int d = 0; d < 128; ++d) { s1 += lf[d] * lf[128 + d]; s2 += lf[256 + d] * lf[384 + d]; }
        const float lam_init = 0.8f - 0.6f * expf(-0.3f * (float)tid);
        ((float*)(((unsigned char*)a.ws) + WS_MISC))[tid] = expf(s1) - expf(s2) + lam_init; }
}
__device__ __forceinline__ void p0_tr_unit(const DArgs& a, LAS unsigned char* lds, int tu, const int tid) {
    const int wave = __builtin_amdgcn_readfirstlane(tid >> 6), lane = tid & 63;
    LAS float* scr = (LAS float*)(lds + wave * 16384);
    constexpr int I_IN = 64 * 512, I_OUT = 64 * 128, I_L = I_IN + I_OUT;
#pragma unroll 1
    for (int s = 0; s < 8; ++s) { int it = tu * 64 + wave * 8 + s; const int l = it / I_L; it -= l * I_L;
        if (it < I_IN) p0_transpose_item(((const float*)a.in[11]) + (size_t)l * 4096 * 16384, 4096, 16384, (bf16*)(((unsigned char*)a.ws) + WS_WIN) + (size_t)l * 16384 * 4096, scr, it, lane);
        else p0_transpose_item(((const float*)a.in[12]) + (size_t)l * 4096 * 4096, 4096, 4096, (bf16*)(((unsigned char*)a.ws) + WS_WOUT) + (size_t)l * 4096 * 4096, scr, it - I_IN, lane); }
}
__device__ __forceinline__ void p0_cv_unit(const DArgs& a, int cu, const int tid) {
    const size_t idx0 = (size_t)cu * 4096 + tid; const int arr = (int)(idx0 >> 20);
    const float* src = (arr == 0 ? ((const float*)a.in[2]) : arr == 1 ? ((const float*)a.in[3]) : arr == 2 ? ((const float*)a.in[4]) : ((const float*)a.in[5]));
    bf16* dst = (bf16*)(((unsigned char*)a.ws) + WS_CACHE) + (size_t)arr * 8388608;
    f32x4 xv[16];
#pragma unroll
    for (int s = 0; s < 8; ++s) { const size_t e = ((idx0 + 512 * s) & 1048575u) * 8; xv[2 * s] = __builtin_nontemporal_load((const f32x4*)(src + e)); xv[2 * s + 1] = __builtin_nontemporal_load((const f32x4*)(src + e + 4)); }
    __builtin_amdgcn_sched_barrier(0);
#pragma unroll
    for (int s = 0; s < 8; ++s) { const size_t e = ((idx0 + 512 * s) & 1048575u) * 8; const f32x4 x0 = xv[2 * s], x1 = xv[2 * s + 1];
        v4u o; o.x = pk2(x0[0], x0[1]); o.y = pk2(x0[2], x0[3]); o.z = pk2(x1[0], x1[1]); o.w = pk2(x1[2], x1[3]);
        *(v4u*)(dst + e) = o; }
}

template <bool XBF> __device__ __forceinline__ void ln_phase(const DArgs& a, LAS unsigned char* lds, int mode, int lprev, bool hnext, int lnext, const int tid) {
    const int wave = __builtin_amdgcn_readfirstlane(tid >> 6), G = gridDim.x; int lane = tid & 63;
    bf16* H = (bf16*)(((unsigned char*)a.ws) + WS_H);
    const float* modn = (const float*)(((unsigned char*)a.ws) + WS_MOD) + (size_t)lnext * 9 * 12288;
    const int rpw = (MTOT + G - 1) / G, r0 = blockIdx.x * rpw, r1 = (r0 + rpw < MTOT) ? r0 + rpw : MTOT;
    if (r0 >= MTOT) return;
    const int vecA = r0 < MP ? 8 : ((r0 - MP) >> 11), vecB = (r1 - 1) < MP ? 8 : ((r1 - 1 - MP) >> 11);
    LAS f32x4* LG = (LAS f32x4*)lds; LAS f32x4* LB = LG + 1024; LAS f32x4* LSH = LG + 2048; LAS f32x4* LSC = LG + 3072;
    __syncthreads();
    for (int i = tid; i < 1024; i += 512) {
        if (mode == 1) { LG[i] = *(const f32x4*)(((const float*)a.in[13]) + (size_t)lprev * DM + 4 * i); LB[i] = *(const f32x4*)(((const float*)a.in[14]) + (size_t)lprev * DM + 4 * i); }
        if (mode == 0 || hnext) {
            LSH[i] = *(const f32x4*)(modn + (size_t)vecA * 12288 + 4 * i); LSC[i] = *(const f32x4*)(modn + (size_t)vecA * 12288 + 4096 + 4 * i);
            LSH[4096 + i] = *(const f32x4*)(modn + (size_t)vecB * 12288 + 4 * i); LSC[4096 + i] = *(const f32x4*)(modn + (size_t)vecB * 12288 + 4096 + 4 * i); } }
    __syncthreads();
    const int m0 = r0 + wave;
    f32x4 nx[16]; v2u ny[16];
    constexpr bool xbf = XBF;
#define LN_SRC(m) ((m) < MP ? ((const float*)a.in[0]) + (size_t)(m) * DM : ((const float*)a.in[1]) + (size_t)((m) - MP) * DM)
#define LN_LOAD(m) do { if (xbf) { const bf16* q_ = (const bf16*)(((unsigned char*)a.ws) + WS_X1) + (size_t)(m) * DM + 4 * lane; _Pragma("unroll") for (int j = 0; j < 16; ++j) { const v2u t_ = __builtin_nontemporal_load((const v2u*)(q_ + 256 * j)); nx[j][0] = __uint_as_float(t_.x); nx[j][1] = __uint_as_float(t_.y); } } \
        else { const float* s_ = LN_SRC(m) + 4 * lane; _Pragma("unroll") for (int j = 0; j < 16; ++j) nx[j] = __builtin_nontemporal_load((const f32x4*)(s_ + 256 * j)); } \
        if (mode == 1) { const bf16* y_ = H + (size_t)(m) * DM + 4 * lane; _Pragma("unroll") for (int j = 0; j < 16; ++j) ny[j] = __builtin_nontemporal_load((const v2u*)(y_ + 256 * j)); } } while (0)
    if (m0 < r1) LN_LOAD(m0);
    for (int m = m0; m < r1; m += NWAVES) {
        asm volatile("" : "+v"(lane));
        f32x4 v[16]; float s = 0.f;
#pragma unroll
        for (int j = 0; j < 16; ++j) { v[j] = xbf ? (f32x4){bflo(__float_as_uint(nx[j][0])), bfhi(__float_as_uint(nx[j][0])), bflo(__float_as_uint(nx[j][1])), bfhi(__float_as_uint(nx[j][1]))} : nx[j];
            if (mode == 1) { v[j] = v[j] * 1.41421356237f + (f32x4){bflo(ny[j].x), bfhi(ny[j].x), bflo(ny[j].y), bfhi(ny[j].y)}; }
            s += (v[j][0] + v[j][1]) + (v[j][2] + v[j][3]); }
        if (m + NWAVES < r1) LN_LOAD(m + NWAVES);
        float mean = wave_sum(s) * (1.f / DM); float s2 = 0.f;
#pragma unroll
        for (int j = 0; j < 16; ++j) { v[j] = v[j] - mean; s2 += (v[j][0] * v[j][0] + v[j][1] * v[j][1]) + (v[j][2] * v[j][2] + v[j][3] * v[j][3]); }
        float rstd = 1.f / sqrtf(wave_sum(s2) * (1.f / DM) + LN_EPS);
        if (mode == 1) {
            float* dst = ((float*)a.out) + (size_t)m * DM; bf16* dstb = (bf16*)(((unsigned char*)a.ws) + WS_X1) + (size_t)m * DM;
            s = 0.f;
#pragma unroll
            for (int j = 0; j < 16; ++j) { const f32x4 gg = LG[lane + 64 * j], bb = LB[lane + 64 * j];
                v[j] = v[j] * rstd * gg + bb;
                if (hnext) { v2u o; o.x = pk2(v[j][0], v[j][1]); o.y = pk2(v[j][2], v[j][3]); __builtin_nontemporal_store(o, (v2u*)(dstb + 4 * lane + 256 * j)); }
                else __builtin_nontemporal_store(v[j], (f32x4*)(dst + 4 * lane + 256 * j));
                s += (v[j][0] + v[j][1]) + (v[j][2] + v[j][3]);
                if ((j & 3) == 3) asm volatile("" ::: "memory"); }
            if (!hnext) continue;
            mean = wave_sum(s) * (1.f / DM); s2 = 0.f;
#pragma unroll
            for (int j = 0; j < 16; ++j) { v[j] = v[j] - mean; s2 += (v[j][0] * v[j][0] + v[j][1] * v[j][1]) + (v[j][2] * v[j][2] + v[j][3] * v[j][3]); }
            rstd = 1.f / sqrtf(wave_sum(s2) * (1.f / DM) + LN_EPS);
        }
        const int vec = m < MP ? 8 : ((m - MP) >> 11);
        const int so = (vec == vecA) ? 0 : 4096;
        bf16* hrow = H + (size_t)m * DM;
#pragma unroll
        for (int j = 0; j < 16; ++j) { const f32x4 ss = LSC[so + lane + 64 * j], hh = LSH[so + lane + 64 * j];
            const f32x4 y = v[j] * rstd * (ss + 1.f) + hh;
            v2u o; o.x = pk2(y[0], y[1]); o.y = pk2(y[2], y[3]);
            *(v2u*)(hrow + 4 * lane + 256 * j) = o;
            if ((j & 3) == 3) asm volatile("" ::: "memory"); }
    }
#undef LN_SRC
#undef LN_LOAD
}

__device__ __forceinline__ void rf_phase(const DArgs& a, int l, const int tid) {
    const int wave = __builtin_amdgcn_readfirstlane(tid >> 6), lane = tid & 63, G = gridDim.x;
    for (int it = blockIdx.x * NWAVES + wave; it < MP * 8; it += G * NWAVES) { const int m = it >> 3, part = it & 7, grp = part >> 1, hf = part & 1;
        const int gcol = (grp == 0 ? 1024 : grp == 1 ? 2048 : grp == 2 ? 5120 : 6144) + hf * 512 + 8 * lane;
        const v4u w = *(const v4u*)((const bf16*)(((unsigned char*)a.ws) + WS_P) + (size_t)m * DIN + gcol);
        float* dst = ((float*)a.out) + O_NAK + (size_t)grp * 8388608 + ((size_t)((m >> 8) * 2 + l) * 256 + (m & 255)) * 1024 + hf * 512 + 8 * lane;
        *(f32x4*)dst = (f32x4){bflo(w.x), bfhi(w.x), bflo(w.y), bfhi(w.y)}; *(f32x4*)(dst + 4) = (f32x4){bflo(w.z), bfhi(w.z), bflo(w.w), bfhi(w.w)}; }
    const float* OFf = (const float*)(((unsigned char*)a.ws) + WS_OF); const float* OFb = (const float*)(((unsigned char*)a.ws) + WS_OF2);
    const bf16* P = (const bf16*)(((unsigned char*)a.ws) + WS_P); bf16* Y = (bf16*)(((unsigned char*)a.ws) + WS_Y);
    for (int m = blockIdx.x * NWAVES + wave; m < MTOT; m += G * NWAVES) {
        const float* pf = OFf + (size_t)m * 1024 + 16 * lane; const float* pb = OFb + (size_t)m * 1024 + 16 * lane;
        f32x4 x[4]; float s = 0.f;
#pragma unroll
        for (int k = 0; k < 4; ++k) { x[k] = *(const f32x4*)(pf + 4 * k) + *(const f32x4*)(pb + 4 * k); s += (x[k][0] + x[k][1]) + (x[k][2] + x[k][3]); }
        const v4u g0 = *(const v4u*)(P + (size_t)m * DIN + 11264 + 16 * lane), g1 = *(const v4u*)(P + (size_t)m * DIN + 11264 + 16 * lane + 8);
        s += __shfl_xor(s, 1); s += __shfl_xor(s, 2); s += __shfl_xor(s, 4);
        const float mean = s * (1.f / 128.f); float vs = 0.f;
#pragma unroll
        for (int k = 0; k < 4; ++k) { x[k] = x[k] - mean; vs += (x[k][0] * x[k][0] + x[k][1] * x[k][1]) + (x[k][2] * x[k][2] + x[k][3] * x[k][3]); }
        vs += __shfl_xor(vs, 1); vs += __shfl_xor(vs, 2); vs += __shfl_xor(vs, 4);
        const float rstd = 1.f / sqrtf(vs * (1.f / 128.f) + LN_EPS);
        v4u o0, o1;
        o0.x = pk2(x[0][0] * rstd * siluf(bflo(g0.x)), x[0][1] * rstd * siluf(bfhi(g0.x))); o0.y = pk2(x[0][2] * rstd * siluf(bflo(g0.y)), x[0][3] * rstd * siluf(bfhi(g0.y)));
        o0.z = pk2(x[1][0] * rstd * siluf(bflo(g0.z)), x[1][1] * rstd * siluf(bfhi(g0.z))); o0.w = pk2(x[1][2] * rstd * siluf(bflo(g0.w)), x[1][3] * rstd * siluf(bfhi(g0.w)));
        o1.x = pk2(x[2][0] * rstd * siluf(bflo(g1.x)), x[2][1] * rstd * siluf(bfhi(g1.x))); o1.y = pk2(x[2][2] * rstd * siluf(bflo(g1.y)), x[2][3] * rstd * siluf(bfhi(g1.y)));
        o1.z = pk2(x[3][0] * rstd * siluf(bflo(g1.z)), x[3][1] * rstd * siluf(bfhi(g1.z))); o1.w = pk2(x[3][2] * rstd * siluf(bflo(g1.w)), x[3][3] * rstd * siluf(bfhi(g1.w)));
        *(v4u*)(Y + (size_t)m * DM + 2048 + 16 * lane) = o0; *(v4u*)(Y + (size_t)m * DM + 2048 + 16 * lane + 8) = o1;
    }
}

constexpr int MU_CS = 64, MU_BS = 256, MU_AS = 512, MU_BP = 64, MU_CP = 128, MU_AP = 128, MU_CV = 320, MU_CO = 64;
constexpr int MO_CS = 0, MO_BS = MO_CS + MU_CS, MO_AS = MO_BS + MU_BS, MO_BP = MO_AS + MU_AS, MO_CP = MO_BP + MU_BP, MO_AP = MO_CP + MU_CP, MO_CV = MO_AP + MU_AP, MO_CO = MO_CV + MU_CV, MU_TOTAL = MO_CO + MU_CO;

__device__ __forceinline__ void mixer_phase(const DArgs& a, unsigned char* ldsg, int l, const int wid, int qsel = 0) {
    const int G = gridDim.x;
    LAS unsigned char* lds = (LAS unsigned char*)ldsg;
    volatile LAS unsigned* slot = (volatile LAS unsigned*)(lds + MISC_OFF);
    LAS float* biasS = (LAS float*)(lds + BIAS_OFF);
    gu32* ctr = (gu32*)(((unsigned char*)a.ws) + WS_CTL) + (l ? CW_QM1 : CW_QM0) + qsel * 256;
    const bf16* P = (const bf16*)(((unsigned char*)a.ws) + WS_P); bf16* Y = (bf16*)(((unsigned char*)a.ws) + WS_Y);
    const bf16* cNAK = (const bf16*)(((unsigned char*)a.ws) + WS_CACHE); const bf16* cNAV = cNAK + 8388608; const bf16* cDFK = cNAV + 8388608; const bf16* cDFV = cDFK + 8388608;
    const float lam = ((const float*)(((unsigned char*)a.ws) + WS_MISC))[l];
    const float one_m_lam_init = __uint_as_float(__builtin_amdgcn_readfirstlane(__float_as_uint(l ? (1.f - 0.35550906759f) : 0.8f)));
#define UNIT_HEAD(q) ((G != 256) ? (q) : ((q) < 64 ? (q) : ((q) < 256 ? MO_BS + ((q) & 7) * 32 + (((q) - 64) >> 3) : MO_BS + (((q) - 256) & 7) * 32 + 24 + (((q) - 256) >> 3))))
    constexpr int ILV = (DEF_UNITS / 2) * 5;
    const int qtotal = MU_TOTAL + (l == 0 ? DEF_UNITS : 0);
#define UNIT_OF(q) unit_of_(q, G, l)
    auto unit_of_ = [](int q, int G, int l) -> int {
        if (q < 320) return UNIT_HEAD(q);
        if (l != 0) return q;
        const int qq = q - 320;
        if (qq >= ILV) return 320 + (ILV / 5) * 3 + (qq - ILV);
        const int k = qq / 5, r = qq - 5 * k;
        if (r == 1 || r == 3) return MU_TOTAL + 2 * k + (r == 3 ? 1 : 0);
        return 320 + 3 * k + (r == 0 ? 0 : (r == 2 ? 1 : 2));
    };
    int qpos = blockIdx.x; int u = UNIT_OF(qpos);
    while (qpos < qtotal) {
        if (qsel && (u < PROBE_ULO || u >= PROBE_UHI)) { qpos = next_unit(ctr, slot, G, wid); u = UNIT_OF(qpos); continue; }
        int tid = TIDNOW(wid); asm volatile("" : "+v"(tid));
        const int lane = tid & 63;
        if (u >= MU_TOTAL) {
            const int d = u - MU_TOTAL;
            if (d < DEF_GEMV) p0_gemv_unit(a, lds, P0_GEMV + d, tid); else p0_tr_unit(a, lds, P0_TR + (d - DEF_GEMV), tid);
        } else
#ifndef NO_ATT
        if ((u >= MO_BS && u < MO_CP) || (u >= MO_AP && u < MO_CV)) {
            int kind, b, h, qb;
            if (u < MO_AS) { kind = 0; const int x = u - MO_BS; b = x >> 5; h = (x >> 3) & 3; qb = x & 7; }
            else if (u < MO_BP) { kind = 1; const int x = u - MO_AS; b = x >> 6; h = (x >> 3) & 7; qb = x & 7; }
            else if (u < MO_CP) { kind = 2; const int x = u - MO_BP; b = x >> 2; h = x & 3; qb = 0; }
            else { kind = 3; const int x = u - MO_AP; b = x >> 3; h = x & 7; qb = 0; }
            const bool isB = (kind == 0 || kind == 2), isS = (kind < 2);
            const int seq0 = isS ? MP + b * 2048 : b * 256;
            const int row0 = seq0 + qb * 256;
            att::Run R; R.ldq = DIN; R.ld0 = 1024; R.ld1 = DIN; R.nt0 = isS ? 8 : 0; R.na = (kind == 1); R.rq0 = qb * 4; R.rlo = 0;
#ifdef PROBE_DMA0
            R.probe = qsel; R.Kz = (const bf16*)(((unsigned char*)a.ws) + WS_OF2);
#endif
            const size_t coff = ((size_t)(b * 2 + l) * 512) * 1024;
            if (kind == 1) {
                int lo = qb * 4 - 4; lo = lo < 0 ? 0 : (lo > 24 ? 24 : lo); int hi4 = qb * 4 + 3 - 4; hi4 = hi4 < 0 ? 0 : (hi4 > 24 ? 24 : hi4); hi4 += 7;
                int nloc = hi4 - lo + 1; nloc += (nloc & 1);
                R.rlo = lo; R.NT = 8 + nloc;
                R.Q = P + (size_t)row0 * DIN + h * 128;
                R.K0 = cNAK + coff + h * 128; R.V0 = cNAV + coff + h * 128;
                R.K1 = P + (size_t)(seq0 + lo * 64) * DIN + 1024 + h * 128; R.V1 = P + (size_t)(seq0 + lo * 64) * DIN + 2048 + h * 128;
                __syncthreads();
                for (int i = tid; i < 15 * 32; i += 512) { const int dr = i >> 5, dc = i & 31; biasS[i] = dc < 31 ? ((const float*)a.in[15])[((size_t)(l * 8 + h) * 15 + dr) * 31 + dc] * (1.f / att::SCALE) : 0.f; }
                __syncthreads();
            } else if (kind == 3) {
                R.NT = 4; R.Q = P + (size_t)row0 * DIN + h * 128; R.K0 = R.Q; R.V0 = R.Q;
                R.K1 = P + (size_t)seq0 * DIN + 1024 + h * 128; R.V1 = P + (size_t)seq0 * DIN + 2048 + h * 128;
            } else {
                R.NT = isS ? 40 : 4;
            }
            f32x4* pk4 = (f32x4*)(((unsigned char*)a.ws) + WS_DP4) + (size_t)blockIdx.x * 32768;
            float* T = (float*)(ldsg + wid * 16384);
            if (!isB) {
                att::f32x16 o[4];
                att::attn_run(R, (char*)ldsg, (float*)(ldsg + WSF_OFF), biasS, o, tid);
                int t2 = TIDNOW(wid); asm volatile("" : "+v"(t2)); const int lz = t2 & 63;
                att::store_tile(o, T, lz, P + (size_t)(row0 + 32 * wid) * DIN + 3072 + h * 128, DIN, Y + (size_t)(row0 + 32 * wid) * DM + h * 128, DM, nullptr);
            } else {
                for (int t = 0; t < 2; ++t) {
                    R.Q = P + (size_t)row0 * DIN + 4096 + h * 256 + t * 128;
                    R.K0 = cDFK + coff + h * 256 + t * 128; R.V0 = cDFV + coff + h * 256;
                    R.K1 = P + (size_t)seq0 * DIN + 5120 + h * 256 + t * 128; R.V1 = P + (size_t)seq0 * DIN + 6144 + h * 256;
                    att::f32x16 o[4], o2[4];
                    att::attn_run_w(R, (char*)ldsg, (float*)(ldsg + WSF_OFF), o, o2, tid);
                    int t2 = TIDNOW(wid); asm volatile("" : "+v"(t2));
                    const unsigned ub = (unsigned)t2 + (unsigned)t * 16384u;
#pragma unroll
                    for (int d0 = 0; d0 < 4; ++d0) {
#pragma unroll
                        for (int g = 0; g < 4; ++g) pk4[ub + (unsigned)((d0 * 4 + g) * 512)] = (f32x4){o[d0][4 * g], o[d0][4 * g + 1], o[d0][4 * g + 2], o[d0][4 * g + 3]};
                        asm volatile("" ::: "memory"); }
#pragma unroll
                    for (int d0 = 0; d0 < 4; ++d0) {
#pragma unroll
                        for (int g = 0; g < 4; ++g) pk4[ub + 8192u + (unsigned)((d0 * 4 + g) * 512)] = (f32x4){o2[d0][4 * g], o2[d0][4 * g + 1], o2[d0][4 * g + 2], o2[d0][4 * g + 3]};
                        asm volatile("" ::: "memory"); }
                }
                int t3 = TIDNOW(wid); asm volatile("" : "+v"(t3));
                const int lz = t3 & 63; const unsigned utid = (unsigned)t3;
                float* rsL = (float*)(ldsg + WSF_OFF) + wid * 64;
                const float* sub = ((const float*)a.in[17]) + (size_t)l * 256;
                const bf16* gb = P + (size_t)(row0 + 32 * wid) * DIN + 7168 + h * 256; bf16* yb = Y + (size_t)(row0 + 32 * wid) * DM + 1024 + h * 256;
#ifdef PROBE_DMA0
                long ldy_ = DM; if (qsel) { yb = (bf16*)(((unsigned char*)a.ws) + WS_DP) + (size_t)(blockIdx.x * 8 + wid) * 8192; ldy_ = 256; }
#else
                constexpr long ldy_ = DM;
#endif
#define PARK_LD16(slot, d0) ({ const f32x4 a_ = pk4[(slot) + (unsigned)(((d0) * 4 + 0) * 512) + utid], b_ = pk4[(slot) + (unsigned)(((d0) * 4 + 1) * 512) + utid], \
                                 c_ = pk4[(slot) + (unsigned)(((d0) * 4 + 2) * 512) + utid], d_ = pk4[(slot) + (unsigned)(((d0) * 4 + 3) * 512) + utid]; \
                                 (att::f32x16){a_[0], a_[1], a_[2], a_[3], b_[0], b_[1], b_[2], b_[3], c_[0], c_[1], c_[2], c_[3], d_[0], d_[1], d_[2], d_[3]}; })
                att::f32x16 ssv = {};
                { att::f32x16 dl[4];
#pragma unroll
                  for (int d0 = 0; d0 < 4; ++d0) { const att::f32x16 va = PARK_LD16(0u, d0), vc = PARK_LD16(16384u, d0); dl[d0] = va - vc * lam; ssv += dl[d0] * dl[d0]; asm volatile("" ::: "memory"); }
                  att::tile_put(dl, T, lz); }
                att::f32x16 dh[4];
#pragma unroll
                for (int d0 = 0; d0 < 4; ++d0) { const att::f32x16 va = PARK_LD16(8192u, d0), vc = PARK_LD16(24576u, d0); dh[d0] = va - vc * lam; ssv += dh[d0] * dh[d0]; asm volatile("" ::: "memory"); }
#undef PARK_LD16
#pragma unroll
                for (int r = 0; r < 16; ++r) { float ss = ssv[r];
                    ss += att::swz_xor<1>(ss); ss += att::swz_xor<2>(ss); ss += att::swz_xor<4>(ss); ss += att::swz_xor<8>(ss); ss += att::swz_xor<16>(ss);
                    const float rs = one_m_lam_init / sqrtf(ss * (1.f / 256.f) + LN_EPS);
                    if ((lz & 31) == 0) rsL[att::crow(r, lz >> 5)] = rs; }
                att::tile_emit(T, lz, gb, DIN, yb, ldy_, sub, rsL);
                att::tile_put(dh, T, lz);
                att::tile_emit(T, lz, gb + 128, DIN, yb + 128, ldy_, sub + 128, rsL);
            }
        } else
#endif
#ifndef NO_RET
        if (u < MO_CV) {
            const bool isS = (u < MO_BS); const int x = isS ? u - MO_CS : u - MO_CP; const int b = x >> 3, h = x & 7;
            const int seq0 = isS ? MP + b * 2048 : b * 256;
#pragma unroll 1
            for (int dir = 0; dir < 2; ++dir) {
                const float xx = ((const float*)a.in[18])[(size_t)l * 16 + dir * 8 + h]; const float yv = expf(-xx);
                const float ln1p = (yv < 1e-3f) ? yv * (1.f - yv * (0.5f - yv * (1.f / 3.f))) : logf(1.f + yv);
                const float lg2 = -ln1p * 1.4426950408889634f;
                const float* s0 = isS ? ((const float*)a.in[6]) + ((size_t)((b * 2 + l) * 2 + dir) * 8 + h) * 16384 : nullptr;
                float* sout = isS ? nullptr : ((float*)a.out) + O_ST + ((size_t)((b * 2 + l) * 2 + dir) * 8 + h) * 16384;
                int td = TIDNOW(wid); asm volatile("" : "+v"(td));
                ret::ret_unit((char*)ldsg, P + (size_t)seq0 * DIN, (float*)(((unsigned char*)a.ws) + WS_OF) + (size_t)seq0 * 1024, dir ? Y + (size_t)seq0 * DM : nullptr, s0, sout, isS ? 16 : 2, h, dir, lg2, td);
            }
        } else
#endif
        if (u < MO_CO) {
            ret::conv_unit(P, Y, ((const float*)a.in[19]) + (size_t)l * 3072, (u - MO_CV) * 64, tid);
        } else {
            const int rbase = (u - MO_CO) * 64;
#pragma unroll 1
            for (int it0 = wid; it0 < 64 * 8; it0 += NWAVES * 8) {
                v4u w[8];
#pragma unroll
                for (int j = 0; j < 8; ++j) { const int it = it0 + j * NWAVES, m = rbase + (it >> 3), part = it & 7, grp = part >> 1, hf = part & 1;
                    const int gcol = (grp == 0 ? 1024 : grp == 1 ? 2048 : grp == 2 ? 5120 : 6144) + hf * 512 + 8 * lane;
                    w[j] = *(const v4u*)(P + (size_t)m * DIN + gcol); }
#pragma unroll
                for (int j = 0; j < 8; ++j) { const int it = it0 + j * NWAVES, m = rbase + (it >> 3), part = it & 7, grp = part >> 1, hf = part & 1;
                    float* dst = ((float*)a.out) + O_NAK + (size_t)grp * 8388608 + ((size_t)((m >> 8) * 2 + l) * 256 + (m & 255)) * 1024 + hf * 512 + 8 * lane;
                    __builtin_nontemporal_store((f32x4){bflo(w[j].x), bfhi(w[j].x), bflo(w[j].y), bfhi(w[j].y)}, (f32x4*)dst); __builtin_nontemporal_store((f32x4){bflo(w[j].z), bfhi(w[j].z), bflo(w[j].w), bfhi(w[j].w)}, (f32x4*)(dst + 4)); }
            }
        }
        qpos = next_unit(ctr, slot, G, wid); u = UNIT_OF(qpos);
    }
#undef UNIT_OF
#undef UNIT_HEAD
}

__global__ void __launch_bounds__(NWAVES * 64, 2) mk_fwd(Args args) {
    extern __shared__ __attribute__((aligned(16))) unsigned char lds[];
    LAS unsigned char* L = (LAS unsigned char*)lds;
    volatile LAS unsigned* MISC = (volatile LAS unsigned*)(L + MISC_OFF);
    const int tid = threadIdx.x, G = gridDim.x;
    const int wk = __builtin_amdgcn_readfirstlane(tid >> 6);
    for (int u = tid; u < (LDS_BYTES - MISC_OFF) / 4; u += NWAVES * 64) MISC[u] = 0u;
    __syncthreads();
    gu32* ctl = (gu32*)((GAS unsigned char*)args.ws + WS_CTL);
    XcdBarrier bar; bar.bar = (unsigned*)ctl + CW_BAR; bar.x = 0; bar.st = nullptr; bar.wk = wk;
    if (N_LAUNCHES == 1) { bar = xcd_barrier_post((unsigned*)ctl + CW_BAR, MISC + 8); bar.wk = wk; }
#define GRID_BAR() do { if (N_LAUNCHES == 1) xcd_barrier(bar); } while (0)
    const int lo = args.ph_lo, hi = args.ph_hi;
#define ARGS_HERE(name) DArgs name; { const Args* p_ = (const Args*)__builtin_amdgcn_kernarg_segment_ptr(); asm volatile("" : "+s"(p_)); \
        _Pragma("unroll") for (int i_ = 0; i_ < 20; ++i_) name.in[i_] = (GAS const float*)p_->in[i_]; \
        name.out = (GAS float*)p_->out; name.ws = (GAS unsigned char*)p_->ws; }
#ifndef PH_MASK
#define PH_MASK 0xfff
#endif
#define ARGS_PLAIN(name) DArgs name; { _Pragma("unroll") for (int i_ = 0; i_ < 20; ++i_) name.in[i_] = (GAS const float*)args.in[i_]; name.out = (GAS float*)args.out; name.ws = (GAS unsigned char*)args.ws; }
#define IN(k) (((PH_MASK >> ((k) > 5 ? (k) - 4 : (k))) & 1) && ((N_LAUNCHES == 1 && PROBE_RELAUNCH_LO < 0) || (lo <= (k) && (k) < hi)))
#define BOTH(k) (IN(k) && IN((k) + 1))
    ARGS_PLAIN(da);

    if (IN(0)) {
        int u = blockIdx.x;
        while (u < P0_UNITS) {
            const int tu_ = TIDNOW(wk);
            if (u < P0_GEMV) p0_gemv_unit(da, L, u, tu_);
            else if (u < P0_GEMV + P0_MISC) p0_misc_unit(da, tu_);
            else if (u < P0_GEMV + P0_MISC + P0_TR) p0_tr_unit(da, L, u - (P0_GEMV + P0_MISC), tu_);
            else p0_cv_unit(da, u - (P0_GEMV + P0_MISC + P0_TR), tu_);
            u = next_unit(ctl + CW_Q0, MISC + 4, G, wk);
        }
        if (PROBE_MASK & 1) { GRID_BAR(); u = blockIdx.x;
            while (u < P0_UNITS) {
                const int tu_ = TIDNOW(wk);
                if (u < P0_GEMV) p0_gemv_unit(da, L, u, tu_);
                else if (u < P0_GEMV + P0_MISC) p0_misc_unit(da, tu_);
                else if (u < P0_GEMV + P0_MISC + P0_TR) p0_tr_unit(da, L, u - (P0_GEMV + P0_MISC), tu_);
                else p0_cv_unit(da, u - (P0_GEMV + P0_MISC + P0_TR), tu_);
                u = next_unit(ctl + CW_Q0 + 256, MISC + 4, G, wk);
            } }
        if (BOTH(0)) GRID_BAR();
    }
    if (IN(1)) { int tp = TIDNOW(wk); asm volatile("" : "+v"(tp)); ln_phase<false>(da, L, 0, 0, true, 0, tp); if (BOTH(1)) GRID_BAR(); }

#pragma unroll 1
    for (int l = 0; l < 2; ++l) {
        const int pb = 2 + 4 * l;
        if (IN(pb)) {

            pg8::Gemm g{(const bf16*)((unsigned char*)da.ws + WS_H), (const bf16*)((unsigned char*)da.ws + WS_WIN) + (size_t)l * 16384 * 4096};
            pg8::SyncOrder<MTOT, DIN> S; S.init(G, (int)blockIdx.x);
            pg8::EpiIn E{(bf16*)((unsigned char*)da.ws + WS_P), (const float*)((unsigned char*)da.ws + WS_ROPE)};
            int tp = TIDNOW(wk); asm volatile("" : "+v"(tp));
#pragma unroll 1
            for (int rep = 0; rep < ((PROBE_MASK & 2) ? 2 : 1); ++rep) { if (rep) GRID_BAR(); asm volatile("" : "+v"(tp));
            pg8::gemm_phase<pg8::EpiIn, pg8::SyncOrder<MTOT, DIN>, DM, false>(L, g, S, E, tp); }
            if (BOTH(pb)) GRID_BAR();
        }
        if (IN(pb + 1)) { mixer_phase(da, lds, l, wk); if (PROBE_MASK & 4) { GRID_BAR(); mixer_phase(da, lds, l, wk, 1); } if (BOTH(pb + 1)) GRID_BAR(); }
        if (IN(pb + 2)) {

            pg8::Gemm g{(const bf16*)((unsigned char*)da.ws + WS_Y), (const bf16*)((unsigned char*)da.ws + WS_WOUT) + (size_t)l * 4096 * 4096};
            pg8::SyncOrder<MTOT, DM> S; S.init(G, (int)blockIdx.x);
            pg8::EpiOut E{(bf16*)((unsigned char*)da.ws + WS_H), (const float*)((unsigned char*)da.ws + WS_MOD) + (size_t)l * 9 * 12288};
            int tp = TIDNOW(wk); asm volatile("" : "+v"(tp));
#pragma unroll 1
            for (int rep = 0; rep < (((PROBE_MASK & 8) && l == 0) ? 2 : 1); ++rep) { if (rep) GRID_BAR(); asm volatile("" : "+v"(tp));
            pg8::gemm_phase<pg8::EpiOut, pg8::SyncOrder<MTOT, DM>, DM, false>(L, g, S, E, tp); }
            if (BOTH(pb + 2)) GRID_BAR();
        }
        if (IN(pb + 3)) { int tp = TIDNOW(wk); asm volatile("" : "+v"(tp)); if (l == 0) ln_phase<false>(da, L, 1, 0, true, 1, tp); else ln_phase<true>(da, L, 1, 1, false, 1, tp); if (BOTH(pb + 3)) GRID_BAR(); }
    }
#undef IN
#undef BOTH
#undef GRID_BAR
}

extern "C" void kernel_launch(void* const* d_in, const int* in_sizes, int n_in, void* d_out, int out_size, void* d_ws, size_t ws_size, hipStream_t stream) {
    static int grid = 0;
    if (grid == 0) {
        if (n_in != 20 || ws_size < WS_END) { fprintf(stderr, "kernel_launch: unexpected n_in %d / ws_size %zu (need %zu)\n", n_in, ws_size, (size_t)WS_END); grid = -1; return; }
        int dev = 0, cus = 0, per_cu = 0;
        if (hipGetDevice(&dev) != hipSuccess || hipDeviceGetAttribute(&cus, hipDeviceAttributeMultiprocessorCount, dev) != hipSuccess) { grid = -1; return; }
        if (hipFuncSetAttribute((const void*)mk_fwd, hipFuncAttributeMaxDynamicSharedMemorySize, LDS_BYTES) != hipSuccess) { fprintf(stderr, "kernel_launch: hipFuncSetAttribute failed\n"); grid = -1; return; }
        if (hipOccupancyMaxActiveBlocksPerMultiprocessor(&per_cu, (const void*)mk_fwd, NWAVES * 64, LDS_BYTES) != hipSuccess || per_cu < 1)
            fprintf(stderr, "kernel_launch: occupancy query reports %d workgroups per CU\n", per_cu);
        (void)hipGetLastError();
        grid = cus;
    }
    if (grid < 0) return;
    if (hipMemsetAsync((char*)d_ws + WS_CTL, 0, CTL_ZERO_BYTES, stream) != hipSuccess) return;
    Args a{};
    for (int i = 0; i < 20; ++i) a.in[i] = (const float*)d_in[i];
    a.out = (float*)d_out; a.ws = (unsigned char*)d_ws;
    if (N_LAUNCHES == 1) { a.ph_lo = 0; a.ph_hi = N_PHASES; hipLaunchKernelGGL(mk_fwd, dim3(grid), dim3(NWAVES * 64), LDS_BYTES, stream, a);
        if (PROBE_RELAUNCH_LO >= 0) { a.ph_lo = PROBE_RELAUNCH_LO; a.ph_hi = PROBE_RELAUNCH_HI; hipLaunchKernelGGL(mk_fwd, dim3(grid), dim3(NWAVES * 64), LDS_BYTES, stream, a); } }
    else for (int p = 0; p < N_PHASES; ++p) { a.ph_lo = p; a.ph_hi = p + 1; hipLaunchKernelGGL(mk_fwd, dim3(grid), dim3(NWAVES * 64), LDS_BYTES, stream, a); }
    const hipError_t le = hipPeekAtLastError();
    if (le != hipSuccess) fprintf(stderr, "kernel_launch: launch failed: %s\n", hipGetErrorName(le));
}
```

```cpp
#include <hip/hip_runtime.h>
#include <cstdio>
#include <cstdint>
namespace pg8 {
#define PG8_LAS __attribute__((address_space(3)))
typedef unsigned short bf16_t;
typedef short bf16x8 __attribute__((ext_vector_type(8)));
typedef float f32x4 __attribute__((ext_vector_type(4)));
typedef unsigned u32x4 __attribute__((ext_vector_type(4)));
typedef unsigned u32x2 __attribute__((ext_vector_type(2)));
constexpr int BM = 256, BK = 64, HALF = 128, HTB = HALF * BK * 2, STAGE_BYTES = 8 * HTB, NXCD = 8, WGM = 8;

__host__ __device__ __forceinline__ int lds_byte(int r, int c) { const int st = (r >> 4) * 2 + (c >> 5), rr = r & 15, cc = c & 31, ob = rr * 64 + cc * 2; return st * 1024 + (ob ^ (((ob >> 9) & 1) << 5)); }
__host__ __device__ __forceinline__ void stage_rc(int b, int& R, int& C) { const int st = b / 1024, sb = b % 1024, swz = sb ^ (((sb >> 9) & 1) << 5); R = (st >> 1) * 16 + swz / 64; C = (st & 1) * 32 + (swz % 64) / 2; }
__host__ __device__ __forceinline__ int perm32(int rho) { const int n = rho >> 4, i = rho & 15; return 8 * (i >> 2) + 4 * n + (i & 3); }
__host__ __device__ __forceinline__ int ropemap(int R) { const int wc = R >> 5, n = (R >> 4) & 1, j = R & 15; return 64 * (wc >> 1) + 32 * n + 16 * (wc & 1) + j; }

struct Unit { int pm, pn; };
struct Gemm { const bf16_t* A; const bf16_t* Bt; };

template <int M_, int N_> struct StaticOrder {
    static constexpr int nM = M_ / BM, nN = N_ / BM, nwg = nM * nN;
    int G, c;
    __host__ __device__ void init(int G_, int c_) { G = G_; c = c_; }
    __host__ __device__ bool next(int i, Unit& u) const {
        const int L = i * G + c; if (L >= nwg) return false;
        int wgid = L; { constexpr int q = nwg / NXCD, r = nwg % NXCD; const int xcd = wgid % NXCD, off = wgid / NXCD; wgid = (xcd < r ? xcd * (q + 1) : r * (q + 1) + (xcd - r) * q) + off; }
        constexpr int nig = WGM * nN; const int gid = wgid / nig, fm = gid * WGM, gsz = (nM - fm) < WGM ? (nM - fm) : WGM;
        u.pm = fm + ((wgid % nig) % gsz); u.pn = (wgid % nig) / gsz; return true;
    }
    __device__ __forceinline__ void a_ready(const Unit&) const {}
    __device__ __forceinline__ void done(const Unit&) const {}
};

template <int M_, int N_> struct SyncOrder {
    static constexpr int nM = M_ / BM, nN = N_ / BM, nwg = nM * nN;
    static_assert(nM == 80 && nN % 16 == 0, "SyncOrder is laid out for 80 row panels");
    int G, c;
    __host__ __device__ void init(int G_, int c_) { G = G_; c = c_; }
    __host__ __device__ bool next(int i, Unit& u) const {
        if (G != 256) { const int L = i * G + c; if (L >= nwg) return false; u.pm = L / nN; u.pn = L % nN; return true; }
        const int x = c & 7, sl = c >> 3;
#ifndef SYNC_ORDER_COLS
#define SYNC_ORDER_COLS 1
#endif
        if (SYNC_ORDER_COLS) {
            constexpr int cpx = nN / 8, rpr = 32 / cpx;
            if (i >= nM / rpr) return false;
            u.pn = cpx * x + (sl % cpx); u.pm = rpr * i + (sl / cpx); return true;
        }
        if (i < nN / 4) { u.pm = 8 * x + (sl & 7); u.pn = 4 * i + (sl >> 3); return true; }
        const int i2 = i - nN / 4; if (i2 >= nN / 16) return false;
        u.pm = 64 + 2 * x + (sl & 1); u.pn = 16 * i2 + (sl >> 1); return true;
    }
    __device__ __forceinline__ void a_ready(const Unit&) const {}
    __device__ __forceinline__ void done(const Unit&) const {}
};

__device__ __forceinline__ const char* uni_ptr(const char* p) { const unsigned long long v = (unsigned long long)p; const unsigned lo = __builtin_amdgcn_readfirstlane((unsigned)v), hi = __builtin_amdgcn_readfirstlane((unsigned)(v >> 32)); return (const char*)(((unsigned long long)hi << 32) | lo); }
__device__ __forceinline__ unsigned cvt_pk_bf16(float lo, float hi) { unsigned r; asm volatile("v_cvt_pk_bf16_f32 %0, %1, %2" : "=v"(r) : "v"(lo), "v"(hi)); return r; }

struct EpiIn {
    static constexpr bool PERM = true, ROPE = true, AFTER_DRAIN = false;
    bf16_t* P; const float* rope;
    __device__ __forceinline__ void operator()(const f32x4 (&acc)[2][2][4][2], const Unit& u, int wr, int wc, int fr, int fq) const {
        const int row0 = u.pm * BM + wr * 64 + fr; const int g = u.pn >> 2;
        const int hsel = wc >> 1, f0 = 16 * (wc & 1) + 4 * fq;
        const int colh = u.pn * BM + 64 * hsel + 16 * (wc & 1) + 4 * fq;
        const bool roped = u.pm >= 16 && (g == 4 || g == 5 || g == 8 || g == 9);
        f32x4 ccv[2][4], ssv[2][4];
#pragma unroll
        for (int ai = 0; ai < 2; ++ai)
#pragma unroll
            for (int m = 0; m < 4; ++m) { ccv[ai][m] = (f32x4){1.f, 1.f, 1.f, 1.f}; ssv[ai][m] = (f32x4){0.f, 0.f, 0.f, 0.f}; }
        if (roped) {
#pragma unroll
            for (int ai = 0; ai < 2; ++ai)
#pragma unroll
                for (int m = 0; m < 4; ++m) { const int row = row0 + ai * HALF + m * 16; const int t = (row - 4096) & 2047; const int pos = hsel ? (t & 63) : (t >> 6);
                    const f32x4 cs0 = *(const f32x4*)(rope + (pos * 32 + f0) * 2), cs1 = *(const f32x4*)(rope + (pos * 32 + f0) * 2 + 4);
                    ccv[ai][m] = (f32x4){cs0[0], cs0[2], cs1[0], cs1[2]}; ssv[ai][m] = (f32x4){cs0[1], cs0[3], cs1[1], cs1[3]}; }
        }
#pragma unroll
        for (int ai = 0; ai < 2; ++ai)
#pragma unroll
            for (int m = 0; m < 4; ++m) {
                const int row = row0 + ai * HALF + m * 16;
                const f32x4 cc = ccv[ai][m], ss = ssv[ai][m];
                bf16_t* rowp = P + (size_t)row * 16384 + colh + ((fq & 1) ? 28 : 0);
#pragma unroll
                for (int bj = 0; bj < 2; ++bj) { const f32x4 x1 = acc[ai][bj][m][0], x2 = acc[ai][bj][m][1];
                    const f32x4 o1 = x1 * cc - x2 * ss, o2 = x2 * cc + x1 * ss;
                    const unsigned w1x = cvt_pk_bf16(o1[0], o1[1]), w1y = cvt_pk_bf16(o1[2], o1[3]), w2x = cvt_pk_bf16(o2[0], o2[1]), w2y = cvt_pk_bf16(o2[2], o2[3]);
                    const auto r0 = __builtin_amdgcn_permlane16_swap(w1x, w2x, false, false), r1 = __builtin_amdgcn_permlane16_swap(w1y, w2y, false, false);
                    u32x4 w; w.x = r0[0]; w.y = r1[0]; w.z = r0[1]; w.w = r1[1];
                    *(u32x4*)(rowp + bj * HALF) = w; }
            }
    }
};

struct EpiOut {
    static constexpr bool PERM = true, ROPE = false, AFTER_DRAIN = false;
    bf16_t* O; const float* mod;
    __device__ __forceinline__ void operator()(const f32x4 (&acc)[2][2][4][2], const Unit& u, int wr, int wc, int fr, int fq) const {
        const int row0 = u.pm * BM + wr * 64 + fr, col0 = u.pn * BM + wc * 32 + 8 * fq;
        const int vec = u.pm < 16 ? 8 : ((u.pm - 16) >> 3);
        const float* gate = mod + (size_t)vec * 12288 + 8192 + col0;
        f32x4 gv[2][2];
#pragma unroll
        for (int bj = 0; bj < 2; ++bj)
#pragma unroll
            for (int n = 0; n < 2; ++n) gv[bj][n] = *(const f32x4*)(gate + bj * HALF + 4 * n);
#pragma unroll
        for (int ai = 0; ai < 2; ++ai)
#pragma unroll
            for (int m = 0; m < 4; ++m) { bf16_t* rowp = O + (size_t)(row0 + ai * HALF + m * 16) * 4096 + col0;
#pragma unroll
                for (int bj = 0; bj < 2; ++bj) { const f32x4 v0 = acc[ai][bj][m][0] * gv[bj][0], v1 = acc[ai][bj][m][1] * gv[bj][1];
                    u32x4 w; w.x = cvt_pk_bf16(v0[0], v0[1]); w.y = cvt_pk_bf16(v0[2], v0[3]); w.z = cvt_pk_bf16(v1[0], v1[1]); w.w = cvt_pk_bf16(v1[2], v1[3]);
                    *(u32x4*)(rowp + bj * HALF) = w; } }
    }
};

template <class Epi, class Sched, int K, bool ALIGN_EPI = true, bool SP2 = true>
__device__ __forceinline__ void gemm_phase(PG8_LAS unsigned char* lds, const Gemm g, const Sched& S, const Epi& E, const int tid) {
    const int wid = __builtin_amdgcn_readfirstlane(tid >> 6), lane = tid & 63, wr = wid >> 2, wc = wid & 3, fr = lane & 15, fq = lane >> 4;
    constexpr int nt = K / BK;
    unsigned voffA[2], voffB[2];
#pragma unroll
    for (int i = 0; i < 2; ++i) { int R, C; stage_rc(tid * 16 + i * 8192, R, C); const int Rb = Epi::ROPE ? ropemap(R) : (Epi::PERM ? ((R & ~31) + perm32(R & 31)) : R);
        voffA[i] = (unsigned)(R * K + C) * 2u; voffB[i] = (unsigned)(Rb * K + C) * 2u; }
    constexpr size_t kstep = (size_t)(BK * 2);
    constexpr size_t hstep = (size_t)HALF * K * 2;
    constexpr size_t tstep = 2 * hstep;
    const unsigned ldsw = (unsigned)wid * 1024u;
    const int aoff = lds_byte(wr * 64 + fr, fq * 8), boff = lds_byte(wc * 32 + fr, fq * 8);
#define PG8_SA(b, h) (((b) * 2 + (h)) * HTB)
#define PG8_SB(b, h) ((4 + (b) * 2 + (h)) * HTB)
#define PG8_STAGE(bufoff, gbase, voff) do { _Pragma("unroll") for (int _i = 0; _i < 2; ++_i) \
        __builtin_amdgcn_global_load_lds((const unsigned*)((const char*)(gbase) + (voff)[_i]), (PG8_LAS unsigned*)(lds + (bufoff) + ldsw + _i * 8192), 16, 0, 0); } while (0)
#ifndef PG8_B_AUX
#define PG8_B_AUX 0
#endif
#define PG8_STAGEB(bufoff, gbase, voff) do { _Pragma("unroll") for (int _i = 0; _i < 2; ++_i) \
        __builtin_amdgcn_global_load_lds((const unsigned*)((const char*)(gbase) + (voff)[_i]), (PG8_LAS unsigned*)(lds + (bufoff) + ldsw + _i * 8192), 16, 0, PG8_B_AUX); } while (0)
#define PG8_LDA(dst, b, h) do { _Pragma("unroll") for (int m = 0; m < 4; ++m) _Pragma("unroll") for (int k = 0; k < 2; ++k) dst[m][k] = *(const PG8_LAS bf16x8*)(lds + PG8_SA(b, h) + aoff + m * 2048 + k * 1024); } while (0)
#define PG8_LDB(dst, b, h) do { _Pragma("unroll") for (int n = 0; n < 2; ++n) _Pragma("unroll") for (int k = 0; k < 2; ++k) dst[n][k] = *(const PG8_LAS bf16x8*)(lds + PG8_SB(b, h) + boff + n * 2048 + k * 1024); } while (0)
#define PG8_MMA(ai, bj, At, Bt) do { __builtin_amdgcn_s_setprio(1); _Pragma("unroll") for (int m = 0; m < 4; ++m) _Pragma("unroll") for (int n = 0; n < 2; ++n) _Pragma("unroll") for (int k = 0; k < 2; ++k) \
        acc[ai][bj][m][n] = __builtin_amdgcn_mfma_f32_16x16x32_bf16(Bt[n][k], At[m][k], acc[ai][bj][m][n], 0, 0, 0); __builtin_amdgcn_s_setprio(0); } while (0)
#define PG8_WAIT_V(n) asm volatile("s_waitcnt vmcnt(" #n ")" ::: "memory")
#define PG8_WAIT_L(n) asm volatile("s_waitcnt lgkmcnt(" #n ")" ::: "memory")
#define PG8_BAR __builtin_amdgcn_s_barrier()
#define PG8_SCHED __builtin_amdgcn_sched_barrier(0)
    Unit cur, nxt; int ui = 0;
    if (!S.next(0, cur)) return;
    f32x4 acc[2][2][4][2];
#pragma unroll
    for (int a = 0; a < 2; ++a)
#pragma unroll
        for (int b = 0; b < 2; ++b)
#pragma unroll
            for (int m = 0; m < 4; ++m)
#pragma unroll
                for (int n = 0; n < 2; ++n) acc[a][b][m][n] = (f32x4){0.f, 0.f, 0.f, 0.f};
    bf16x8 At[4][2], B0[2][2], B1[2][2];
    const char* cA = (const char*)g.A + (size_t)cur.pm * tstep; const char* cB = (const char*)g.Bt + (size_t)cur.pn * tstep;
    S.a_ready(cur);
    if constexpr (SP2) {
        PG8_STAGEB(PG8_SB(0, 0), cB, voffB); PG8_STAGEB(PG8_SB(0, 1), cB + hstep, voffB); PG8_STAGE(PG8_SA(0, 0), cA, voffA); PG8_STAGE(PG8_SA(0, 1), cA + hstep, voffA);
        if (wr == 1) PG8_BAR;
        PG8_WAIT_V(2); PG8_BAR;
        PG8_STAGEB(PG8_SB(1, 0), cB + kstep, voffB); PG8_STAGE(PG8_SA(1, 0), cA + kstep, voffA); PG8_STAGEB(PG8_SB(1, 1), cB + hstep + kstep, voffB);
        PG8_WAIT_V(6); PG8_BAR;
    } else {
        PG8_STAGEB(PG8_SB(0, 0), cB, voffB); PG8_STAGE(PG8_SA(0, 0), cA, voffA); PG8_STAGEB(PG8_SB(0, 1), cB + hstep, voffB); PG8_STAGE(PG8_SA(0, 1), cA + hstep, voffA);
        if (wr == 1) PG8_BAR;
        PG8_WAIT_V(4); PG8_BAR;
        PG8_STAGEB(PG8_SB(1, 0), cB + kstep, voffB); PG8_STAGE(PG8_SA(1, 0), cA + kstep, voffA); PG8_STAGEB(PG8_SB(1, 1), cB + hstep + kstep, voffB);
        PG8_WAIT_V(6); PG8_BAR;
    }
    for (;;) {
        const bool has_next = S.next(ui + 1, nxt);
        const char* nA = has_next ? (const char*)g.A + (size_t)nxt.pm * tstep : cA; const char* nB = has_next ? (const char*)g.Bt + (size_t)nxt.pn * tstep : cB;
        for (int t = 0; t < nt; t += 2) {
            const bool last = (t == nt - 2);
            const char* a1 = cA + (size_t)(t + 1) * kstep;
            const char* a2 = last ? nA : cA + (size_t)(t + 2) * kstep; const char* b2 = last ? nB : cB + (size_t)(t + 2) * kstep;
            a1 = uni_ptr(a1); a2 = uni_ptr(a2); b2 = uni_ptr(b2);
            const char* a3 = a2 + kstep; const char* b3 = b2 + kstep;
            if (last && has_next) S.a_ready(nxt);
            if constexpr (SP2) {
            PG8_LDB(B0, 0, 0); PG8_LDB(B1, 0, 1); PG8_SCHED; PG8_LDA(At, 0, 0); PG8_STAGE(PG8_SA(1, 1), a1 + hstep, voffA);
            PG8_WAIT_V(8); PG8_WAIT_L(0); PG8_BAR; PG8_MMA(0, 0, At, B0); PG8_MMA(0, 1, At, B1); PG8_BAR; PG8_SCHED;
            PG8_LDA(At, 0, 1); PG8_STAGEB(PG8_SB(0, 0), b2, voffB); PG8_STAGEB(PG8_SB(0, 1), b2 + hstep, voffB); PG8_STAGE(PG8_SA(0, 0), a2, voffA);
            PG8_WAIT_V(8); PG8_WAIT_L(0); PG8_BAR; PG8_MMA(1, 0, At, B0); PG8_MMA(1, 1, At, B1); PG8_BAR; PG8_SCHED;
            PG8_LDB(B0, 1, 0); PG8_LDB(B1, 1, 1); PG8_SCHED; PG8_LDA(At, 1, 0); PG8_STAGE(PG8_SA(0, 1), a2 + hstep, voffA);
            PG8_WAIT_V(8); PG8_WAIT_L(0); PG8_BAR; PG8_MMA(0, 0, At, B0); PG8_MMA(0, 1, At, B1); PG8_BAR; PG8_SCHED;
            PG8_LDA(At, 1, 1); PG8_STAGEB(PG8_SB(1, 0), b3, voffB); PG8_STAGEB(PG8_SB(1, 1), b3 + hstep, voffB); PG8_STAGE(PG8_SA(1, 0), a3, voffA);
            PG8_WAIT_V(8); PG8_WAIT_L(0); PG8_BAR; PG8_MMA(1, 0, At, B0); PG8_MMA(1, 1, At, B1); PG8_BAR; PG8_SCHED;
            } else {
            PG8_LDB(B0, 0, 0); PG8_SCHED; PG8_LDA(At, 0, 0); PG8_STAGE(PG8_SA(1, 1), a1 + hstep, voffA);
            PG8_WAIT_L(8); PG8_BAR; PG8_WAIT_L(0); PG8_MMA(0, 0, At, B0); PG8_BAR; PG8_SCHED;
            PG8_LDB(B1, 0, 1); PG8_STAGEB(PG8_SB(0, 0), b2, voffB);
            PG8_BAR; PG8_WAIT_L(0); PG8_MMA(0, 1, At, B1); PG8_BAR;
            PG8_LDA(At, 0, 1); PG8_STAGE(PG8_SA(0, 0), a2, voffA);
            PG8_BAR; PG8_WAIT_L(0); PG8_MMA(1, 0, At, B0); PG8_BAR; PG8_SCHED;
            PG8_STAGEB(PG8_SB(0, 1), b2 + hstep, voffB);
            PG8_WAIT_V(6); PG8_BAR; PG8_MMA(1, 1, At, B1); PG8_BAR;
            PG8_LDB(B0, 1, 0); PG8_SCHED; PG8_LDA(At, 1, 0); PG8_STAGE(PG8_SA(0, 1), a2 + hstep, voffA);
            PG8_WAIT_L(8); PG8_BAR; PG8_WAIT_L(0); PG8_MMA(0, 0, At, B0); PG8_BAR; PG8_SCHED;
            PG8_LDB(B1, 1, 1); PG8_STAGEB(PG8_SB(1, 0), b3, voffB);
            PG8_BAR; PG8_WAIT_L(0); PG8_MMA(0, 1, At, B1); PG8_BAR;
            PG8_LDA(At, 1, 1); PG8_STAGE(PG8_SA(1, 0), a3, voffA);
            PG8_BAR; PG8_WAIT_L(0); PG8_MMA(1, 0, At, B0); PG8_BAR; PG8_SCHED;
            PG8_STAGEB(PG8_SB(1, 1), b3 + hstep, voffB);
            PG8_WAIT_V(6); PG8_BAR; PG8_MMA(1, 1, At, B1); PG8_BAR;
            }
        }
        if constexpr (ALIGN_EPI) { if (wr == 0) PG8_BAR; }
        if constexpr (!Epi::AFTER_DRAIN) { int l2_; asm volatile("v_mbcnt_lo_u32_b32 %0, -1, 0\n\tv_mbcnt_hi_u32_b32 %0, -1, %0" : "=v"(l2_)); const int fr2 = l2_ & 15, fq2 = l2_ >> 4;
            E(acc, cur, wr, wc, fr2, fq2); S.done(cur); }
        if (!has_next) break;
#pragma unroll
        for (int a = 0; a < 2; ++a)
#pragma unroll
            for (int b = 0; b < 2; ++b)
#pragma unroll
                for (int m = 0; m < 4; ++m)
#pragma unroll
                    for (int n = 0; n < 2; ++n) acc[a][b][m][n] = (f32x4){0.f, 0.f, 0.f, 0.f};
        cur = nxt; cA = nA; cB = nB; ++ui;
        if constexpr (ALIGN_EPI) { if (wr == 1) PG8_BAR; }
    }
    PG8_WAIT_V(0);
    if constexpr (!ALIGN_EPI) { if (wr == 0) PG8_BAR; }
    PG8_BAR;
#undef PG8_SA
#undef PG8_SB
#undef PG8_STAGE
#undef PG8_STAGEB
#undef PG8_LDA
#undef PG8_LDB
#undef PG8_MMA
#undef PG8_WAIT_V
#undef PG8_WAIT_L
#undef PG8_BAR
#undef PG8_SCHED
}
}
namespace att {
typedef unsigned short u16;
using bf16x8 = __attribute__((ext_vector_type(8))) short;
using s16x4  = __attribute__((ext_vector_type(4))) short;
using f32x16 = __attribute__((ext_vector_type(16))) float;
using u32x4  = __attribute__((ext_vector_type(4))) unsigned;
constexpr int   D = 128, NW = 8, QBLK = 32, KVBLK = 64;
constexpr float SCALE = 0.088388347648318440f;
constexpr float THR = 8.f;
constexpr size_t SHM_V = KVBLK * D * 2, SHM_K = KVBLK * D * 2, SHM_ATTN = 3 * SHM_V + 3 * SHM_K;
#define KSWZ(row, colB) ((row) * 256 + ((colB) ^ (((row) & 7) << 4)))
#define SBAR() __builtin_amdgcn_sched_barrier(0)
__device__ __forceinline__ int crow(int r, int hi) { return (r & 3) + 8 * (r >> 2) + 4 * hi; }
__device__ __forceinline__ unsigned cvtpk(float lo, float hi) { unsigned r; asm volatile("v_cvt_pk_bf16_f32 %0, %1, %2" : "=v"(r) : "v"(lo), "v"(hi)); return r; }
__device__ __forceinline__ bf16x8 ld8(const u16* p) { return *reinterpret_cast<const bf16x8*>(p); }
template <int X> __device__ __forceinline__ float swz_xor(float v) { return __int_as_float(__builtin_amdgcn_ds_swizzle(__float_as_int(v), (X << 10) | 0x1f)); }
__device__ __forceinline__ float sum_xor32(float v) { auto rr = __builtin_amdgcn_permlane32_swap(__float_as_uint(v), __float_as_uint(v), false, false); return __uint_as_float(rr[0]) + __uint_as_float(rr[1]); }

__device__ __forceinline__ void partialSM(f32x16& p0, f32x16& p1, float& m_reg, float& mn, float& alpha) {
  constexpr float C = SCALE * 1.4426950408889634f;
  float pmax = p0[0];
#pragma unroll
  for (int r = 1; r < 16; ++r) pmax = fmaxf(pmax, p0[r]);
#pragma unroll
  for (int r = 0; r < 16; ++r) pmax = fmaxf(pmax, p1[r]);
  { auto rr = __builtin_amdgcn_permlane32_swap(__float_as_uint(pmax), __float_as_uint(pmax), false, false);
    pmax = fmaxf(__uint_as_float(rr[0]), __uint_as_float(rr[1])); }
  if (__builtin_expect(__all(pmax - m_reg <= THR / SCALE), 1)) { mn = m_reg; alpha = 1.f; }
  else { mn = fmaxf(m_reg, pmax); alpha = __builtin_amdgcn_exp2f((m_reg - mn) * C); m_reg = mn; }
  float mnC = -mn * C;
#pragma unroll
  for (int r = 0; r < 16; ++r) p0[r] = fmaf(p0[r], C, mnC);
#pragma unroll
  for (int r = 0; r < 16; ++r) p1[r] = fmaf(p1[r], C, mnC);
#pragma unroll
  for (int r = 0; r < 16; ++r) p0[r] = __builtin_amdgcn_exp2f(p0[r]);
}
__device__ __forceinline__ void finishSM(f32x16& p0, f32x16& p1, float alpha, float& l_reg, bf16x8& pa0, bf16x8& pa1, bf16x8& pa2, bf16x8& pa3) {
#pragma unroll
  for (int r = 0; r < 16; ++r) p1[r] = __builtin_amdgcn_exp2f(p1[r]);
  float ps = 0;
#pragma unroll
  for (int r = 0; r < 16; ++r) ps += p0[r];
#pragma unroll
  for (int r = 0; r < 16; ++r) ps += p1[r];
  { auto rr = __builtin_amdgcn_permlane32_swap(__float_as_uint(ps), __float_as_uint(ps), false, false);
    ps = __uint_as_float(rr[0]) + __uint_as_float(rr[1]); }
  l_reg = l_reg * alpha + ps;
#define PK4(P, BASE, OUT) do { unsigned a0 = cvtpk(P[BASE + 0], P[BASE + 1]), a1 = cvtpk(P[BASE + 2], P[BASE + 3]);   \
    unsigned b0 = cvtpk(P[BASE + 4], P[BASE + 5]), b1 = cvtpk(P[BASE + 6], P[BASE + 7]);                              \
    auto r0 = __builtin_amdgcn_permlane32_swap(a0, b0, false, false); auto r1 = __builtin_amdgcn_permlane32_swap(a1, b1, false, false); \
    u32x4 w = {r0[0], r1[0], r0[1], r1[1]}; OUT = *reinterpret_cast<bf16x8*>(&w); } while (0)
  PK4(p0, 0, pa0); PK4(p0, 8, pa1); PK4(p1, 0, pa2); PK4(p1, 8, pa3);
#undef PK4
}
__device__ __forceinline__ void qkt(f32x16& p0, f32x16& p1, const u16* Ks, const bf16x8* qr, int r32, int hi) {
  p0 = f32x16{}; p1 = f32x16{};
#pragma unroll
  for (int d0 = 0; d0 < 8; ++d0) { int cb = (d0 * 16 + hi * 8) * 2;
    bf16x8 b0 = *reinterpret_cast<const bf16x8*>((const char*)Ks + KSWZ(r32, cb));
    bf16x8 b1 = *reinterpret_cast<const bf16x8*>((const char*)Ks + KSWZ(32 + r32, cb));
    p0 = __builtin_amdgcn_mfma_f32_32x32x16_bf16(b0, qr[d0], p0, 0, 0, 0);
    p1 = __builtin_amdgcn_mfma_f32_32x32x16_bf16(b1, qr[d0], p1, 0, 0, 0); }
}
__device__ __forceinline__ int v_st(int k, int c) { const int kk = (k & ~0xC) | ((k & 4) << 1) | ((k & 8) >> 1); return ((kk >> 3) * 4 + (c >> 5)) * 512 + ((kk & 7) * 32 + (c & 31)) * 2; }
__device__ __forceinline__ int v_rd_base(int lane) { return ((lane & 3) << 3) | (((lane >> 2) & 3) << 6) | (((lane >> 4) & 1) << 5) | (((lane >> 5) & 1) << 8); }
constexpr int v_rd_off(int d0, int ks, int half) { return d0 * 512 + ks * 4096 + half * 2048; }
template <int OFF> __device__ __forceinline__ s16x4 tr_read(int vb) {
  s16x4 r; asm volatile("ds_read_b64_tr_b16 %0, %1 offset:%2" : "=&v"(r) : "v"(vb), "i"(OFF) : "memory"); return r;
}
template <int D0> __device__ __forceinline__ void pv_one(f32x16& od, int vb, bf16x8 pa0, bf16x8 pa1, bf16x8 pa2, bf16x8 pa3) {
  const s16x4 l0 = tr_read<v_rd_off(D0, 0, 0)>(vb), h0 = tr_read<v_rd_off(D0, 0, 1)>(vb), l1 = tr_read<v_rd_off(D0, 1, 0)>(vb), h1 = tr_read<v_rd_off(D0, 1, 1)>(vb);
  const s16x4 l2 = tr_read<v_rd_off(D0, 2, 0)>(vb), h2 = tr_read<v_rd_off(D0, 2, 1)>(vb), l3 = tr_read<v_rd_off(D0, 3, 0)>(vb), h3 = tr_read<v_rd_off(D0, 3, 1)>(vb);
  asm volatile("s_waitcnt lgkmcnt(0)" ::: "memory"); SBAR();
#define PK(L, H) (bf16x8){L[0], L[1], L[2], L[3], H[0], H[1], H[2], H[3]}
  od = __builtin_amdgcn_mfma_f32_32x32x16_bf16(pa0, PK(l0, h0), od, 0, 0, 0);
  od = __builtin_amdgcn_mfma_f32_32x32x16_bf16(pa1, PK(l1, h1), od, 0, 0, 0);
  od = __builtin_amdgcn_mfma_f32_32x32x16_bf16(pa2, PK(l2, h2), od, 0, 0, 0);
  od = __builtin_amdgcn_mfma_f32_32x32x16_bf16(pa3, PK(l3, h3), od, 0, 0, 0);
#undef PK
}
__device__ __forceinline__ void pv_d0(f32x16* o, int vb, bf16x8 pa0, bf16x8 pa1, bf16x8 pa2, bf16x8 pa3) {
  pv_one<0>(o[0], vb, pa0, pa1, pa2, pa3); pv_one<1>(o[1], vb, pa0, pa1, pa2, pa3); pv_one<2>(o[2], vb, pa0, pa1, pa2, pa3); pv_one<3>(o[3], vb, pa0, pa1, pa2, pa3);
}

struct Run { const u16 *Q, *K0, *V0, *K1, *V1; int ldq, ld0, ld1, nt0, NT, na, rq0, rlo;
#ifdef PROBE_DMA0
  int probe; const u16* Kz;
#endif
};
#ifdef PROBE_DMA0
#define PROBE_JT(R, jt) ((R).probe ? 0 : (jt))
#if PROBE_DMA0 == 2
#define PROBE_Z(R, kp, vp, ld) if ((R).probe) { kp = (R).Kz; vp = (R).Kz; ld = 1024; }
#else
#define PROBE_Z(R, kp, vp, ld)
#endif
#else
#define PROBE_JT(R, jt) (jt)
#define PROBE_Z(R, kp, vp, ld)
#endif

__device__ __forceinline__ void na_apply(f32x16& p0, f32x16& p1, int rk, int rq, int cq, int hi, const __attribute__((address_space(3))) float* biasS) {
  int w0 = rq - 4; w0 = w0 < 0 ? 0 : (w0 > 24 ? 24 : w0);
  if (rk < w0 || rk >= w0 + 8) {
#pragma unroll
    for (int r = 0; r < 16; ++r) { p0[r] = -1e30f; p1[r] = -1e30f; }
    return;
  }
  int c0 = cq - 8; c0 = c0 < 0 ? 0 : (c0 > 48 ? 48 : c0);
  const __attribute__((address_space(3))) float* bl = biasS + (rk - rq + 7) * 32 + (15 - cq + 4 * hi);
  const int dd = 4 * hi - c0;
#pragma unroll
  for (int r = 0; r < 16; ++r) {
    const int kc = (r & 3) + 8 * (r >> 2);
    { const bool ok = (unsigned)(dd + kc) < 16u; const float b = bl[kc]; p0[r] = ok ? p0[r] + b : -1e30f; }
    { const bool ok = (unsigned)(dd + kc + 32) < 16u; const float b = bl[kc + 32]; p1[r] = ok ? p1[r] + b : -1e30f; }
    if ((r & 3) == 3) asm volatile("" ::: "memory");
  }
}

template <int OFF> __device__ __forceinline__ bf16x8 rd128(int addr) { bf16x8 r; asm volatile("ds_read_b128 %0, %1 offset:%2" : "=&v"(r) : "v"(addr), "i"(OFF) : "memory"); return r; }
constexpr int voff2(int g, int ks, int hf) { return (g >> 2) * 16384 + (g & 3) * 512 + ks * 4096 + hf * 2048; }
#define LGKM(n) do { asm volatile("s_waitcnt lgkmcnt(" #n ")" ::: "memory"); SBAR(); } while (0)
__device__ __forceinline__ void attn_run_w(const Run& R, char* lds, float* wsf_all, f32x16 (&o)[4], f32x16 (&o2)[4], int tid) {
  typedef __attribute__((address_space(3))) unsigned lds_u32;
  const int wid = __builtin_amdgcn_readfirstlane(tid >> 6), lane = tid & 63, r32 = lane & 31, hi = lane >> 5;
  const int gB = wid >> 2;
  u16* K_lds = (u16*)lds; u16* V_lds = (u16*)(lds + 2 * SHM_K); char* Q_lds = lds + 2 * SHM_K + 4 * SHM_V + wid * 4096;
  float* wsf = wsf_all + wid * 64; float* li_l = wsf; float* al_l = wsf + 32;
  float m_reg = -1e30f, l_reg = 0;
#pragma unroll
  for (int d = 0; d < 4; ++d) { o[d] = f32x16{}; o2[d] = f32x16{}; }
  int krow[2], kcol[2], vrow[2], vcol[2];
#pragma unroll
  for (int i = 0; i < 2; ++i) { const int b = i * 8192 + wid * 1024 + lane * 16;
    krow[i] = b >> 8; kcol[i] = ((b & 255) ^ ((krow[i] & 7) << 4)) >> 1;
    const int sub = b >> 9, kk = (sub >> 2) * 8 + ((b & 511) >> 6); vcol[i] = (sub & 3) * 32 + ((b & 63) >> 1); vrow[i] = (kk & ~0xC) | ((kk & 4) << 1) | ((kk & 8) >> 1); }
  const int vb0 = (int)(uintptr_t)V_lds + v_rd_base(lane);
  const int kb0 = (int)(uintptr_t)K_lds + r32 * 256, kxr = (r32 & 7) << 4;
  const int qa0 = (int)(uintptr_t)Q_lds + r32 * 32 + hi * 16;
#define TILEPTR(jt) const int jt_ = (jt); const u16* kp_; const u16* vp_; int ld_; \
    if (jt_ < R.nt0) { ld_ = R.ld0; kp_ = R.K0 + (long)jt_ * 64 * ld_; vp_ = R.V0 + (long)jt_ * 64 * ld_; } \
    else { ld_ = R.ld1; kp_ = R.K1 + (long)(jt_ - R.nt0) * 64 * ld_; vp_ = R.V1 + (long)(jt_ - R.nt0) * 64 * ld_; }
#define SLOADK(jt) do { TILEPTR(jt) (void)vp_; _Pragma("unroll") for (int i_ = 0; i_ < 2; ++i_) \
      __builtin_amdgcn_global_load_lds((const unsigned*)(kp_ + (krow[i_] * ld_ + kcol[i_])), (lds_u32*)((char*)K_lds + (jt_ & 1) * SHM_K + i_ * 8192 + wid * 1024), 16, 0, 0); } while (0)
#define SLOADV(jt) do { TILEPTR(jt) (void)kp_; _Pragma("unroll") for (int hf_ = 0; hf_ < 2; ++hf_) _Pragma("unroll") for (int i_ = 0; i_ < 2; ++i_) \
      __builtin_amdgcn_global_load_lds((const unsigned*)(vp_ + (vrow[i_] * ld_ + vcol[i_] + 128 * hf_)), (lds_u32*)((char*)V_lds + ((jt_ & 1) * 2 + hf_) * SHM_V + i_ * 8192 + wid * 1024), 16, 0, 0); } while (0)
  bf16x8 qr[4]; const int NT = R.NT;
  __syncthreads();
  { const u16* Qw = R.Q + (long)(wid * QBLK + r32) * R.ldq + hi * 8;
#pragma unroll
    for (int d0 = 0; d0 < 4; ++d0) qr[d0] = ld8(Qw + d0 * 16);
#pragma unroll
    for (int d0 = 4; d0 < 8; ++d0) *(bf16x8*)(Q_lds + (d0 - 4) * 1024 + r32 * 32 + hi * 16) = ld8(Qw + d0 * 16); }
  SLOADK(0); SLOADV(0); if (NT > 1) SLOADK(1);
  asm volatile("s_waitcnt vmcnt(0) lgkmcnt(0)" ::: "memory"); __syncthreads();
#define PKF(L, H) (bf16x8){L[0], L[1], L[2], L[3], H[0], H[1], H[2], H[3]}
#define TRG(F, G) do { F[0] = tr_read<voff2(G, 0, 0)>(vb); F[1] = tr_read<voff2(G, 0, 1)>(vb); F[2] = tr_read<voff2(G, 1, 0)>(vb); F[3] = tr_read<voff2(G, 1, 1)>(vb); \
      F[4] = tr_read<voff2(G, 2, 0)>(vb); F[5] = tr_read<voff2(G, 2, 1)>(vb); F[6] = tr_read<voff2(G, 3, 0)>(vb); F[7] = tr_read<voff2(G, 3, 1)>(vb); } while (0)
#define PVG(ACC, F) do { ACC = __builtin_amdgcn_mfma_f32_32x32x16_bf16(pa0, PKF(F[0], F[1]), ACC, 0, 0, 0); ACC = __builtin_amdgcn_mfma_f32_32x32x16_bf16(pa1, PKF(F[2], F[3]), ACC, 0, 0, 0); \
      ACC = __builtin_amdgcn_mfma_f32_32x32x16_bf16(pa2, PKF(F[4], F[5]), ACC, 0, 0, 0); ACC = __builtin_amdgcn_mfma_f32_32x32x16_bf16(pa3, PKF(F[6], F[7]), ACC, 0, 0, 0); } while (0)
#define KR(D0, B0, B1, QF) do { const int ka_ = kc + (((((D0) & 3) * 32) + hi * 16) ^ kxr); B0 = rd128<((D0) >> 2) * 128>(ka_); B1 = rd128<((D0) >> 2) * 128 + 8192>(ka_); \
      if ((D0) >= 4) QF = rd128<(((D0) - 4) & 3) * 1024>(qa0); } while (0)
#define QKS(D0, B0, B1, QF) do { const bf16x8 q_ = ((D0) < 4) ? qr[(D0) & 3] : QF; \
      p0 = __builtin_amdgcn_mfma_f32_32x32x16_bf16(B0, q_, p0, 0, 0, 0); p1 = __builtin_amdgcn_mfma_f32_32x32x16_bf16(B1, q_, p1, 0, 0, 0); } while (0)
#define SEG_BEGIN(s) do { const int s_ = (s); if (!(s_ & 1) && s_ >= 2) { const int t_ = s_ >> 1; if (t_ + 1 < NT) SLOADK(t_ + 1); if (t_ < NT) SLOADV(t_); } } while (0)
#define SEG_END(s) do { if ((s) & 1) { asm volatile("s_waitcnt vmcnt(0)" ::: "memory"); SBAR(); __builtin_amdgcn_s_barrier(); asm volatile("" ::: "memory"); } SBAR(); } while (0)
#define SM_SEG() do { partialSM(p0, p1, m_reg, mn, al); finishSM(p0, p1, al, l_reg, pa0, pa1, pa2, pa3); \
      if (__any(al < 1.f)) { if (hi == 0) al_l[r32] = al; asm volatile("s_waitcnt lgkmcnt(0)" ::: "memory"); \
        _Pragma("unroll") for (int d = 0; d < 4; ++d) _Pragma("unroll") for (int r = 0; r < 16; ++r) { const float a_ = al_l[crow(r, hi)]; o[d][r] *= a_; o2[d][r] *= a_; } } } while (0)
#define M_SEG(DOPV, DOQK, JPV, JQK) do { \
      const int vb = vb0 + ((JPV) & 1) * 2 * (int)SHM_V, kc = kb0 + ((JQK) & 1) * (int)SHM_K; (void)vb; (void)kc; \
      bf16x8 a0, a1, aq, b0, b1, bq, c0, c1, cq; \
      SBAR(); \
      if (DOPV) { s16x4 FA[8], FB[8]; \
        TRG(FA, 0); \
        TRG(FB, 1); LGKM(8); PVG(o[0], FA); \
        TRG(FA, 2); LGKM(8); PVG(o[1], FB); \
        TRG(FB, 3); LGKM(8); PVG(o[2], FA); \
        TRG(FA, 4); LGKM(8); PVG(o[3], FB); \
        TRG(FB, 5); LGKM(8); PVG(o2[0], FA); \
        TRG(FA, 6); LGKM(8); PVG(o2[1], FB); \
        TRG(FB, 7); LGKM(8); PVG(o2[2], FA); \
        LGKM(0); PVG(o2[3], FB); } \
      if (DOQK) { p0 = f32x16{}; p1 = f32x16{}; \
        KR(0, a0, a1, aq); KR(1, b0, b1, bq); KR(2, c0, c1, cq); LGKM(4); QKS(0, a0, a1, aq); \
        KR(3, a0, a1, aq); LGKM(4); QKS(1, b0, b1, bq); \
        KR(4, b0, b1, bq); LGKM(5); QKS(2, c0, c1, cq); \
        KR(5, c0, c1, cq); LGKM(6); QKS(3, a0, a1, aq); \
        KR(6, a0, a1, aq); LGKM(6); QKS(4, b0, b1, bq); \
        KR(7, b0, b1, bq); LGKM(6); QKS(5, c0, c1, cq); \
        LGKM(3); QKS(6, a0, a1, aq); \
        LGKM(0); QKS(7, b0, b1, bq); } } while (0)
  if (!gB) {
    f32x16 p0, p1; bf16x8 pa0, pa1, pa2, pa3; float mn, al;
    M_SEG(0, 1, 0, 0); SEG_END(0);
#pragma unroll 1
    for (int t = 0; t < NT - 1; ++t) {
      SM_SEG(); SEG_END(2 * t + 1);
      SEG_BEGIN(2 * t + 2); M_SEG(1, 1, t, t + 1); SEG_END(2 * t + 2);
    }
    SM_SEG(); SEG_END(2 * NT - 1);
    M_SEG(1, 0, NT - 1, 0); SEG_END(2 * NT);
    SEG_END(2 * NT + 1);
  } else {
    f32x16 p0, p1; bf16x8 pa0, pa1, pa2, pa3; float mn, al;
    SEG_END(0);
    M_SEG(0, 1, 0, 0); SEG_END(1);
    SEG_BEGIN(2); SM_SEG(); SEG_END(2);
#pragma unroll 1
    for (int t = 1; t < NT; ++t) {
      M_SEG(1, 1, t - 1, t); SEG_END(2 * t + 1);
      SEG_BEGIN(2 * t + 2); SM_SEG(); SEG_END(2 * t + 2);
    }
    M_SEG(1, 0, NT - 1, 0); SEG_END(2 * NT + 1);
  }
  if (hi == 0) li_l[r32] = l_reg; asm volatile("s_waitcnt lgkmcnt(0)" ::: "memory");
#pragma unroll
  for (int r = 0; r < 16; ++r) { const float rl = __builtin_amdgcn_rcpf(li_l[crow(r, hi)]);
#pragma unroll
    for (int d0 = 0; d0 < 4; ++d0) { o[d0][r] *= rl; o2[d0][r] *= rl; } }
#undef SEG_BEGIN
#undef SEG_END
#undef SM_SEG
#undef M_SEG
#undef TILEPTR
#undef SLOADK
#undef SLOADV
#undef PKF
#undef TRG
#undef PVG
#undef KR
#undef QKS
}

__device__ __forceinline__ void attn_run(const Run& R, char* lds, float* wsf_all, const __attribute__((address_space(3))) float* biasS, f32x16 (&o)[4], int tid) {
  typedef __attribute__((address_space(3))) unsigned lds_u32;
  const int wid = __builtin_amdgcn_readfirstlane(tid >> 6), lane = tid & 63, r32 = lane & 31, hi = lane >> 5;
  const int gB = wid >> 2;
  u16* K_lds = (u16*)lds; u16* V_lds = (u16*)(lds + 2 * SHM_K);
  float* wsf = wsf_all + wid * 64; float* li_l = wsf; float* al_l = wsf + 32;
  float m_reg = -1e30f, l_reg = 0; bf16x8 qr[8];
#pragma unroll
  for (int d = 0; d < 4; ++d) o[d] = f32x16{};
  int krow[2], kcol[2], vrow[2], vcol[2];
#pragma unroll
  for (int i = 0; i < 2; ++i) { const int b = i * 8192 + wid * 1024 + lane * 16;
    krow[i] = b >> 8; kcol[i] = ((b & 255) ^ ((krow[i] & 7) << 4)) >> 1;
    const int sub = b >> 9, kk = (sub >> 2) * 8 + ((b & 511) >> 6); vcol[i] = (sub & 3) * 32 + ((b & 63) >> 1); vrow[i] = (kk & ~0xC) | ((kk & 4) << 1) | ((kk & 8) >> 1); }
  const int vb0 = (int)(uintptr_t)V_lds + v_rd_base(lane);
  const int kb0 = (int)(uintptr_t)K_lds + r32 * 256, kxr = (r32 & 7) << 4;
  const int na_rq = R.rq0 + (wid >> 1), na_cq = 32 * (wid & 1) + r32;
  int w0n = na_rq - 4; w0n = w0n < 0 ? 0 : (w0n > 24 ? 24 : w0n);
  const int NT = R.NT, nt0 = R.nt0, naf = R.na, rlo = R.rlo;
#define LIVE(j) (!(naf && (j) >= nt0) || ((rlo + ((j) - nt0)) >= w0n && (rlo + ((j) - nt0)) < w0n + 8))
#define TILEPTR(jt) const int jt_ = (jt); const u16* kp_; const u16* vp_; int ld_; \
    if (jt_ < R.nt0) { ld_ = R.ld0; kp_ = R.K0 + (long)jt_ * 64 * ld_; vp_ = R.V0 + (long)jt_ * 64 * ld_; } \
    else { ld_ = R.ld1; kp_ = R.K1 + (long)(jt_ - R.nt0) * 64 * ld_; vp_ = R.V1 + (long)(jt_ - R.nt0) * 64 * ld_; }
#define SLOADK(jt) do { TILEPTR(jt) (void)vp_; _Pragma("unroll") for (int i_ = 0; i_ < 2; ++i_) \
      __builtin_amdgcn_global_load_lds((const unsigned*)(kp_ + (krow[i_] * ld_ + kcol[i_])), (lds_u32*)((char*)K_lds + (jt_ & 1) * SHM_K + i_ * 8192 + wid * 1024), 16, 0, 0); } while (0)
#define SLOADV(jt) do { TILEPTR(jt) (void)kp_; _Pragma("unroll") for (int i_ = 0; i_ < 2; ++i_) \
      __builtin_amdgcn_global_load_lds((const unsigned*)(vp_ + (vrow[i_] * ld_ + vcol[i_])), (lds_u32*)((char*)V_lds + (jt_ & 1) * SHM_V + i_ * 8192 + wid * 1024), 16, 0, 0); } while (0)
  __syncthreads();
  { const u16* Qw = R.Q + (long)(wid * QBLK + r32) * R.ldq + hi * 8;
#pragma unroll
    for (int d0 = 0; d0 < 8; ++d0) qr[d0] = ld8(Qw + d0 * 16); }
  SLOADK(0); SLOADV(0); if (NT > 1) SLOADK(1);
  asm volatile("s_waitcnt vmcnt(0) lgkmcnt(0)" ::: "memory"); __syncthreads();
#define PKF(L, H) (bf16x8){L[0], L[1], L[2], L[3], H[0], H[1], H[2], H[3]}
#define TRG(F, G) do { F[0] = tr_read<voff2(G, 0, 0)>(vb); F[1] = tr_read<voff2(G, 0, 1)>(vb); F[2] = tr_read<voff2(G, 1, 0)>(vb); F[3] = tr_read<voff2(G, 1, 1)>(vb); \
      F[4] = tr_read<voff2(G, 2, 0)>(vb); F[5] = tr_read<voff2(G, 2, 1)>(vb); F[6] = tr_read<voff2(G, 3, 0)>(vb); F[7] = tr_read<voff2(G, 3, 1)>(vb); } while (0)
#define PVG(ACC, F) do { ACC = __builtin_amdgcn_mfma_f32_32x32x16_bf16(pa0, PKF(F[0], F[1]), ACC, 0, 0, 0); ACC = __builtin_amdgcn_mfma_f32_32x32x16_bf16(pa1, PKF(F[2], F[3]), ACC, 0, 0, 0); \
      ACC = __builtin_amdgcn_mfma_f32_32x32x16_bf16(pa2, PKF(F[4], F[5]), ACC, 0, 0, 0); ACC = __builtin_amdgcn_mfma_f32_32x32x16_bf16(pa3, PKF(F[6], F[7]), ACC, 0, 0, 0); } while (0)
#define KR(D0, B0, B1) do { const int ka_ = kc + (((((D0) & 3) * 32) + hi * 16) ^ kxr); B0 = rd128<((D0) >> 2) * 128>(ka_); B1 = rd128<((D0) >> 2) * 128 + 8192>(ka_); } while (0)
#define QKS(D0, B0, B1) do { p0 = __builtin_amdgcn_mfma_f32_32x32x16_bf16(B0, qr[D0], p0, 0, 0, 0); p1 = __builtin_amdgcn_mfma_f32_32x32x16_bf16(B1, qr[D0], p1, 0, 0, 0); } while (0)
#define SEG_BEGIN(s) do { const int s_ = (s); if (!(s_ & 1) && s_ >= 2) { const int t_ = s_ >> 1; if (t_ + 1 < NT) SLOADK(t_ + 1); if (t_ < NT) SLOADV(t_); } } while (0)
#define SEG_END(s) do { if ((s) & 1) { asm volatile("s_waitcnt vmcnt(0)" ::: "memory"); SBAR(); __builtin_amdgcn_s_barrier(); asm volatile("" ::: "memory"); } SBAR(); } while (0)
#define SM_SEG(J) do { const int j_ = (J); if (LIVE(j_)) { \
      if (naf && j_ >= nt0) na_apply(p0, p1, rlo + (j_ - nt0), na_rq, na_cq, hi, biasS); \
      partialSM(p0, p1, m_reg, mn, al); finishSM(p0, p1, al, l_reg, pa0, pa1, pa2, pa3); \
      if (__any(al < 1.f)) { if (hi == 0) al_l[r32] = al; asm volatile("s_waitcnt lgkmcnt(0)" ::: "memory"); \
        _Pragma("unroll") for (int d = 0; d < 4; ++d) _Pragma("unroll") for (int r = 0; r < 16; ++r) o[d][r] *= al_l[crow(r, hi)]; } } } while (0)
#define M_SEG(DOPV, DOQK, JPV, JQK) do { \
      const int vb = vb0 + ((JPV) & 1) * (int)SHM_V, kc = kb0 + ((JQK) & 1) * (int)SHM_K; (void)vb; (void)kc; \
      SBAR(); \
      if (DOPV && LIVE(JPV)) { s16x4 FA[8], FB[8]; \
        TRG(FA, 0); \
        TRG(FB, 1); LGKM(8); PVG(o[0], FA); \
        TRG(FA, 2); LGKM(8); PVG(o[1], FB); \
        TRG(FB, 3); LGKM(8); PVG(o[2], FA); \
        LGKM(0); PVG(o[3], FB); } \
      if (DOQK && LIVE(JQK)) { bf16x8 a0, a1, b0, b1, c0, c1; p0 = f32x16{}; p1 = f32x16{}; \
        KR(0, a0, a1); KR(1, b0, b1); KR(2, c0, c1); LGKM(4); QKS(0, a0, a1); \
        KR(3, a0, a1); LGKM(4); QKS(1, b0, b1); \
        KR(4, b0, b1); LGKM(4); QKS(2, c0, c1); \
        KR(5, c0, c1); LGKM(4); QKS(3, a0, a1); \
        KR(6, a0, a1); LGKM(4); QKS(4, b0, b1); \
        KR(7, b0, b1); LGKM(4); QKS(5, c0, c1); \
        LGKM(2); QKS(6, a0, a1); \
        LGKM(0); QKS(7, b0, b1); } } while (0)
  if (!gB) {
    f32x16 p0 = {}, p1 = {}; bf16x8 pa0 = {}, pa1 = {}, pa2 = {}, pa3 = {}; float mn, al;
    M_SEG(0, 1, 0, 0); SEG_END(0);
#pragma unroll 1
    for (int t = 0; t < NT - 1; ++t) {
      SM_SEG(t); SEG_END(2 * t + 1);
      SEG_BEGIN(2 * t + 2); M_SEG(1, 1, t, t + 1); SEG_END(2 * t + 2);
    }
    SM_SEG(NT - 1); SEG_END(2 * NT - 1);
    M_SEG(1, 0, NT - 1, 0); SEG_END(2 * NT);
    SEG_END(2 * NT + 1);
  } else {
    f32x16 p0 = {}, p1 = {}; bf16x8 pa0 = {}, pa1 = {}, pa2 = {}, pa3 = {}; float mn, al;
    SEG_END(0);
    M_SEG(0, 1, 0, 0); SEG_END(1);
    SEG_BEGIN(2); SM_SEG(0); SEG_END(2);
#pragma unroll 1
    for (int t = 1; t < NT; ++t) {
      M_SEG(1, 1, t - 1, t); SEG_END(2 * t + 1);
      SEG_BEGIN(2 * t + 2); SM_SEG(t); SEG_END(2 * t + 2);
    }
    M_SEG(1, 0, NT - 1, 0); SEG_END(2 * NT + 1);
  }
  if (hi == 0) li_l[r32] = l_reg; asm volatile("s_waitcnt lgkmcnt(0)" ::: "memory");
#pragma unroll
  for (int r = 0; r < 16; ++r) { const float rl = __builtin_amdgcn_rcpf(li_l[crow(r, hi)]);
#pragma unroll
    for (int d0 = 0; d0 < 4; ++d0) o[d0][r] *= rl; }
#undef LIVE
#undef SEG_BEGIN
#undef SEG_END
#undef SM_SEG
#undef M_SEG
#undef TILEPTR
#undef SLOADK
#undef SLOADV
#undef PKF
#undef TRG
#undef PVG
#undef KR
#undef QKS
}

__device__ __forceinline__ void tile_put(const f32x16 (&o)[4], float* T, int lane) {
  const int r32 = lane & 31, hi = lane >> 5;
  float* Tw = T + 4 * hi * 128 + r32;
#pragma unroll
  for (int r = 0; r < 16; ++r)
#pragma unroll
    for (int d0 = 0; d0 < 4; ++d0) Tw[((r & 3) + 8 * (r >> 2)) * 128 + 32 * d0] = hi ? o[d0 ^ 1][r] : o[d0][r];
}
__device__ __forceinline__ void tile_emit(float* T, int lane, const u16* gate, long ldg, u16* y, long ldy, const float* sub, const float* rsc) {
  const int r32 = lane & 31, hi = lane >> 5;
  const int c = 4 * r32;
  float s0 = 1.f, s1 = 1.f, s2 = 1.f, s3 = 1.f;
  if (sub) { s0 = sub[c]; s1 = sub[c + 1]; s2 = sub[c + 2]; s3 = sub[c + 3]; }
  typedef unsigned u32x2_ __attribute__((ext_vector_type(2)));
  u32x2_ gv[16];
#pragma unroll
  for (int it = 0; it < 16; ++it) gv[it] = *(const u32x2_*)(gate + (long)(2 * it + hi) * ldg + c);
  __builtin_amdgcn_sched_barrier(0);
  asm volatile("s_waitcnt lgkmcnt(0)" ::: "memory");
#define SILU_(x) ((x) * __builtin_amdgcn_rcpf(1.f + __builtin_amdgcn_exp2f(-1.4426950408889634f * (x))))
#pragma unroll
  for (int it = 0; it < 16; ++it) { const int row = 2 * it + hi;
    const float* tp = T + row * 128 + (c ^ (((row >> 2) & 1) << 5));
    const float rr = rsc ? rsc[row] : 1.f;
    const float v0 = tp[0] * rr, v1 = tp[1] * rr, v2 = tp[2] * rr, v3 = tp[3] * rr;
    const unsigned g01 = gv[it].x, g23 = gv[it].y;
    const float a0 = __uint_as_float(g01 << 16), a1 = __uint_as_float(g01 & 0xffff0000u), a2 = __uint_as_float(g23 << 16), a3 = __uint_as_float(g23 & 0xffff0000u);
    u32x2_ w; w.x = cvtpk(v0 * s0 * SILU_(a0), v1 * s1 * SILU_(a1)); w.y = cvtpk(v2 * s2 * SILU_(a2), v3 * s3 * SILU_(a3));
    *(u32x2_*)(y + (long)row * ldy + c) = w;
  }
#undef SILU_
  asm volatile("s_waitcnt lgkmcnt(0)" ::: "memory");
}
__device__ __forceinline__ void store_tile(const f32x16 (&o)[4], float* T, int lane, const u16* gate, long ldg, u16* y, long ldy, const float* sub) {
  tile_put(o, T, lane); tile_emit(T, lane, gate, ldg, y, ldy, sub, nullptr);
}
}
namespace ret {
typedef unsigned short u16;
using bf16x8 = __attribute__((ext_vector_type(8))) short;
using f32x4 = __attribute__((ext_vector_type(4))) float;
using u32x2 = __attribute__((ext_vector_type(2))) unsigned;
using u32x4 = __attribute__((ext_vector_type(4))) unsigned;
using s16x4_t = __attribute__((ext_vector_type(4))) short;
#define RSWZ(row, cb) ((row) * 256 + ((cb) ^ (((row) & 15) << 4)))
__device__ __forceinline__ unsigned cvtpk(float lo, float hi) { unsigned r; asm volatile("v_cvt_pk_bf16_f32 %0, %1, %2" : "=v"(r) : "v"(lo), "v"(hi)); return r; }
__device__ __forceinline__ float bf_lo(unsigned w) { return __uint_as_float(w << 16); }
__device__ __forceinline__ float bf_hi(unsigned w) { return __uint_as_float(w & 0xffff0000u); }
__device__ __forceinline__ float silu(float x) { return x * __builtin_amdgcn_rcpf(1.f + __builtin_amdgcn_exp2f(-1.4426950408889634f * x)); }

#define ROFF(row, ch) (256 * (row) + 16 * ((ch) ^ ((((row) & 3) << 2) | (((row) >> 2) & 3))))
struct TrOff { int t0[8], t1[8]; };
__device__ __forceinline__ int troff(int lane, int c, int t) {
  const int g = lane >> 4, q4 = (lane & 15) >> 2, pp = lane & 3;
  const int row = 8 * g + 4 * t + q4;
  return ROFF(row, 2 * c + (pp >> 1)) + 8 * (pp & 1);
}
__device__ __forceinline__ s16x4_t tr16(int addr) { s16x4_t r; asm volatile("ds_read_b64_tr_b16 %0, %1" : "=&v"(r) : "v"(addr) : "memory"); return r; }
template <int OFF> __device__ __forceinline__ s16x4_t tr16o(int addr) { s16x4_t r; asm volatile("ds_read_b64_tr_b16 %0, %1 offset:%2" : "=&v"(r) : "v"(addr), "i"(OFF) : "memory"); return r; }
#define FRAG8(L, H) (bf16x8){L[0], L[1], L[2], L[3], H[0], H[1], H[2], H[3]}
struct TrFrag { s16x4_t l[4], h[4]; };
template <int BASE> __device__ __forceinline__ TrFrag tr_frag(int a0, int a1) {
  TrFrag f;
  f.l[0] = tr16o<BASE>(a0); f.h[0] = tr16o<BASE>(a1); f.l[1] = tr16o<BASE + 8192>(a0); f.h[1] = tr16o<BASE + 8192>(a1);
  f.l[2] = tr16o<BASE + 16384>(a0); f.h[2] = tr16o<BASE + 16384>(a1); f.l[3] = tr16o<BASE + 24576>(a0); f.h[3] = tr16o<BASE + 24576>(a1);
  return f;
}
__device__ __forceinline__ void mm_rr(f32x4 (&acc)[8], const char* XA, const char* XB, int w, int lane) {
  const int r = lane & 15, q = lane >> 4;
  int bo[4];
#pragma unroll
  for (int ks = 0; ks < 4; ++ks) bo[ks] = ROFF(r, 4 * ks + q);
  bf16x8 a[4], bc[4], bn[4];
#pragma unroll
  for (int ks = 0; ks < 4; ++ks) { a[ks] = *(const bf16x8*)(XA + w * 4096 + bo[ks]); bc[ks] = *(const bf16x8*)(XB + bo[ks]); }
#pragma unroll
  for (int n = 0; n < 8; ++n) {
    if (n < 7) {
#pragma unroll
      for (int ks = 0; ks < 4; ++ks) bn[ks] = *(const bf16x8*)(XB + bo[ks] + (n + 1) * 4096); }
#pragma unroll
    for (int ks = 0; ks < 4; ++ks) acc[n] = __builtin_amdgcn_mfma_f32_16x16x32_bf16(bc[ks], a[ks], acc[n], 0, 0, 0);
    asm volatile("" ::: "memory");
#pragma unroll
    for (int ks = 0; ks < 4; ++ks) bc[ks] = bn[ks];
  }
}
template <int BOFF> __device__ __forceinline__ void mm_rt(f32x4 (&acc)[8], const char* XA, const TrOff& tv, int w, int lane) {
  const int r = lane & 15, q = lane >> 4;
  bf16x8 a[4];
#pragma unroll
  for (int ks = 0; ks < 4; ++ks) a[ks] = *(const bf16x8*)(XA + w * 4096 + ROFF(r, 4 * ks + q));
  asm volatile("s_waitcnt lgkmcnt(0)" ::: "memory");
  TrFrag fc = tr_frag<BOFF>(tv.t0[0], tv.t1[0]);
#pragma unroll
  for (int n = 0; n < 8; ++n) {
    TrFrag fn = fc;
    if (n < 7) { fn = tr_frag<BOFF>(tv.t0[n + 1], tv.t1[n + 1]); asm volatile("s_waitcnt lgkmcnt(8)" ::: "memory"); }
    else asm volatile("s_waitcnt lgkmcnt(0)" ::: "memory");
    __builtin_amdgcn_sched_barrier(0);
#pragma unroll
    for (int ks = 0; ks < 4; ++ks) acc[n] = __builtin_amdgcn_mfma_f32_16x16x32_bf16(FRAG8(fc.l[ks], fc.h[ks]), a[ks], acc[n], 0, 0, 0);
    __builtin_amdgcn_sched_barrier(0);
    fc = fn;
  }
}
template <int BOFF> __device__ __forceinline__ void mm_tt2(f32x4 (&acc1)[8], f32x4 (&acc2)[8], int ta0, int ta1, const char* XA2, const TrOff& tv, int w, int lane) {
  const int r = lane & 15, q = lane >> 4;
  bf16x8 a2[4];
#pragma unroll
  for (int ks = 0; ks < 4; ++ks) a2[ks] = *(const bf16x8*)(XA2 + w * 4096 + ROFF(r, 4 * ks + q));
  asm volatile("s_waitcnt lgkmcnt(0)" ::: "memory");
  const TrFrag fa = tr_frag<0>(ta0, ta1);
  TrFrag fc = tr_frag<BOFF>(tv.t0[0], tv.t1[0]);
#pragma unroll
  for (int n = 0; n < 8; ++n) {
    TrFrag fn = fc;
    if (n < 7) { fn = tr_frag<BOFF>(tv.t0[n + 1], tv.t1[n + 1]); asm volatile("s_waitcnt lgkmcnt(8)" ::: "memory"); }
    else asm volatile("s_waitcnt lgkmcnt(0)" ::: "memory");
    __builtin_amdgcn_sched_barrier(0);
#pragma unroll
    for (int ks = 0; ks < 4; ++ks) { const bf16x8 bf = FRAG8(fc.l[ks], fc.h[ks]);
      acc1[n] = __builtin_amdgcn_mfma_f32_16x16x32_bf16(bf, FRAG8(fa.l[ks], fa.h[ks]), acc1[n], 0, 0, 0);
      acc2[n] = __builtin_amdgcn_mfma_f32_16x16x32_bf16(bf, a2[ks], acc2[n], 0, 0, 0); }
    __builtin_amdgcn_sched_barrier(0);
    fc = fn;
  }
}
__device__ __forceinline__ void nat_load(bf16x8 (&v)[4], const u16* src, int tid) {
#pragma unroll
  for (int s = 0; s < 4; ++s) { const int p = tid + 512 * s, row = p >> 4, ch = p & 15; v[s] = *(const bf16x8*)(src + (size_t)row * 16384 + ch * 8); }
}
__device__ __forceinline__ void nat_write(char* X, const bf16x8 (&v)[4], int tid) {
#pragma unroll
  for (int s = 0; s < 4; ++s) { const int p = tid + 512 * s, row = p >> 4, ch = p & 15; *(bf16x8*)(X + ROFF(row, ch)) = v[s]; }
}
__device__ __forceinline__ void nat_write_scaled(char* X, const bf16x8 (&v)[4], int tid, float lg2, int dirb) {
#pragma unroll
  for (int s = 0; s < 4; ++s) { const int p = tid + 512 * s, row = p >> 4, ch = p & 15;
    const float kd = __builtin_amdgcn_exp2f(lg2 * (float)(dirb ? row : 127 - row));
    const u32x4 x = __builtin_bit_cast(u32x4, v[s]); u32x4 y;
#pragma unroll
    for (int k = 0; k < 4; ++k) y[k] = cvtpk(bf_lo(x[k]) * kd, bf_hi(x[k]) * kd);
    *(u32x4*)(X + ROFF(row, ch)) = y; }
}

#define RET_BAR() do { asm volatile("s_waitcnt lgkmcnt(0)" ::: "memory"); __builtin_amdgcn_s_barrier(); asm volatile("" ::: "memory"); } while (0)
__device__ __forceinline__ void ret_unit(char* lds, const u16* P, float* OD, u16* Yfin, const float* s0, float* sout, int nchunk, int h, int dir, float lg2, int tid) {
  const int w = __builtin_amdgcn_readfirstlane(tid >> 6);
  int lane = tid & 63, r = lane & 15, q = lane >> 4;
  char* X0 = lds; char* X1 = lds + 32768; char* X2 = lds + 65536; char* X3 = lds + 98304;
  int i_loc = 16 * w + r;
  f32x4 S[8];
  if (s0) { const float* sp = s0 + (size_t)i_loc * 128 + 4 * q;
#pragma unroll
    for (int n = 0; n < 8; ++n) S[n] = *(const f32x4*)(sp + 16 * n); }
  else {
#pragma unroll
    for (int n = 0; n < 8; ++n) S[n] = (f32x4){0.f, 0.f, 0.f, 0.f}; }
  bf16x8 pq[4], pk[4], pv[4];
  { const u16* Pc = P + (size_t)((dir ? nchunk - 1 : 0) * 128) * 16384;
    nat_load(pq, Pc + 8 * 1024 + h * 128, tid); nat_load(pk, Pc + 9 * 1024 + h * 128, tid); nat_load(pv, Pc + 10 * 1024 + h * 128, tid); }
  __syncthreads();
#pragma unroll
  for (int n = 0; n < 8; ++n) { u32x2 pk2_; pk2_.x = cvtpk(S[n][0], S[n][1]); pk2_.y = cvtpk(S[n][2], S[n][3]); *(u32x2*)(X3 + ROFF(i_loc, 2 * n + (q >> 1)) + 8 * (q & 1)) = pk2_; }
  const float cd = __builtin_amdgcn_exp2f(lg2 * 128.f);
  for (int cs = 0; cs < nchunk; ++cs) {
    asm volatile("" : "+v"(lane));
    r = lane & 15; q = lane >> 4; i_loc = 16 * w + r;
    const int tl = w * 64 + lane;
    const int c = dir ? nchunk - 1 - cs : cs;
    const u16* Pc = P + (size_t)(c * 128) * 16384;
    TrOff tv;
#pragma unroll
    for (int n = 0; n < 8; ++n) { tv.t0[n] = (int)(uintptr_t)X2 + troff(lane, n, 0); tv.t1[n] = (int)(uintptr_t)X2 + troff(lane, n, 1); }
    nat_write(X0, pq, tl); nat_write_scaled(X1, pk, tl, lg2, dir); nat_write(X2, pv, tl);
    RET_BAR();
    f32x4 aA[8], aO[8];
#pragma unroll
    for (int n = 0; n < 8; ++n) { aA[n] = (f32x4){0.f, 0.f, 0.f, 0.f}; aO[n] = (f32x4){0.f, 0.f, 0.f, 0.f}; }
    mm_rr(aA, X0, X1, w, lane);
    mm_rt<32768>(aO, X0, tv, w, lane);
    RET_BAR();
    { const float rf = __builtin_amdgcn_exp2f(lg2 * (float)(dir ? -i_loc : i_loc - 127));
#pragma unroll
      for (int n = 0; n < 8; ++n) { float v[4];
#pragma unroll
        for (int i = 0; i < 4; ++i) { const int j = 16 * n + 4 * q + i; const bool keep = dir ? (j >= i_loc) : (j <= i_loc); v[i] = keep ? aA[n][i] * rf : 0.f; }
        u32x2 pk2_; pk2_.x = cvtpk(v[0], v[1]); pk2_.y = cvtpk(v[2], v[3]);
        *(u32x2*)(X0 + ROFF(i_loc, 2 * n + (q >> 1)) + 8 * (q & 1)) = pk2_; } }
    { const float qdec = __builtin_amdgcn_exp2f(lg2 * (float)(dir ? 128 - i_loc : i_loc + 1));
#pragma unroll
      for (int n = 0; n < 8; ++n) { aO[n] = aO[n] * qdec; S[n] = S[n] * cd; } }
    if (cs + 1 < nchunk) { const u16* Pn = P + (size_t)((dir ? c - 1 : c + 1) * 128) * 16384;
      nat_load(pq, Pn + 8 * 1024 + h * 128, tl); nat_load(pk, Pn + 9 * 1024 + h * 128, tl); nat_load(pv, Pn + 10 * 1024 + h * 128, tl); }
    RET_BAR();
    mm_tt2<0>(S, aO, (int)(uintptr_t)X1 + troff(lane, w, 0), (int)(uintptr_t)X1 + troff(lane, w, 1), X0, tv, w, lane);
    { float* op = OD + (size_t)(c * 128 + i_loc) * 1024 + h * 128 + 4 * q;
      if (!Yfin) {
#pragma unroll
        for (int n = 0; n < 8; ++n) *(f32x4*)(op + 16 * n) = aO[n];
      } else {
        const u16* gp = Pc + (size_t)i_loc * 16384 + 11 * 1024 + h * 128 + 4 * q;
        f32x4 od[8]; u32x2 gwv[8];
#pragma unroll
        for (int n = 0; n < 8; ++n) od[n] = *(const f32x4*)(op + 16 * n);
#pragma unroll
        for (int n = 0; n < 8; ++n) gwv[n] = *(const u32x2*)(gp + 16 * n);
        float sum = 0.f;
#pragma unroll
        for (int n = 0; n < 8; ++n) { aO[n] = aO[n] + od[n]; sum += (aO[n][0] + aO[n][1]) + (aO[n][2] + aO[n][3]); }
        sum += att::swz_xor<16>(sum); sum = att::sum_xor32(sum);
        const float mean = sum * (1.f / 128.f); float vs = 0.f;
#pragma unroll
        for (int n = 0; n < 8; ++n) { const f32x4 d = aO[n] - mean; vs += (d[0] * d[0] + d[1] * d[1]) + (d[2] * d[2] + d[3] * d[3]); }
        vs += att::swz_xor<16>(vs); vs = att::sum_xor32(vs);
        const float rstd = 1.f / sqrtf(vs * (1.f / 128.f) + 1e-6f);
        u16* yp = Yfin + (size_t)(c * 128 + i_loc) * 4096 + 2048 + h * 128 + 4 * q;
#pragma unroll
        for (int n = 0; n < 8; ++n) { const u32x2 gw = gwv[n];
          const float y0 = (aO[n][0] - mean) * rstd * silu(bf_lo(gw.x)), y1 = (aO[n][1] - mean) * rstd * silu(bf_hi(gw.x));
          const float y2 = (aO[n][2] - mean) * rstd * silu(bf_lo(gw.y)), y3 = (aO[n][3] - mean) * rstd * silu(bf_hi(gw.y));
          u32x2 pk; pk.x = cvtpk(y0, y1); pk.y = cvtpk(y2, y3);
          *(u32x2*)(yp + 16 * n) = pk; }
      } }
    RET_BAR();
#pragma unroll
    for (int n = 0; n < 8; ++n) { u32x2 pk2_; pk2_.x = cvtpk(S[n][0], S[n][1]); pk2_.y = cvtpk(S[n][2], S[n][3]); *(u32x2*)(X3 + ROFF(i_loc, 2 * n + (q >> 1)) + 8 * (q & 1)) = pk2_; }
  }
  if (sout) { float* sp = sout + (size_t)i_loc * 128 + 4 * q;
#pragma unroll
    for (int n = 0; n < 8; ++n) *(f32x4*)(sp + 16 * n) = S[n]; }
}

__device__ __forceinline__ void conv_unit(const u16* Pall, u16* Yall, const float* cw, int m0, int tid) {
  const int cg = tid & 127, sub = tid >> 7, c0 = cg * 8;
  float w0[8], w1[8], w2[8];
#pragma unroll
  for (int k = 0; k < 8; ++k) { w0[k] = cw[(c0 + k) * 3 + 0]; w1[k] = cw[(c0 + k) * 3 + 1]; w2[k] = cw[(c0 + k) * 3 + 2]; }
  const int t0 = m0 + sub * 16;
#define SEQPOS(m) ((m) < 4096 ? ((m) & 255) : (((m) - 4096) & 2047))
#define SEQLEN(m) ((m) < 4096 ? 256 : 2048)
  const bool hasP = SEQPOS(t0) > 0, hasN = SEQPOS(t0 + 15) < SEQLEN(t0) - 1;
#pragma unroll 1
  for (int g = 0; g < 4; ++g) {
    const int tb = t0 + 4 * g;
    u32x4 ra[6], rb[6], rbb[4], rgg[4];
#pragma unroll
    for (int k = 0; k < 6; ++k) {
      const bool ok = (k == 0) ? (g > 0 || hasP) : (k == 5) ? (g < 3 || hasN) : true;
      if (ok) { ra[k] = *(const u32x4*)(Pall + (size_t)(tb - 1 + k) * 16384 + 12 * 1024 + c0); rb[k] = *(const u32x4*)(Pall + (size_t)(tb - 1 + k) * 16384 + 14 * 1024 + c0); }
      else { ra[k] = (u32x4){0u, 0u, 0u, 0u}; rb[k] = (u32x4){0u, 0u, 0u, 0u}; }
    }
#pragma unroll
    for (int k = 0; k < 4; ++k) { rbb[k] = *(const u32x4*)(Pall + (size_t)(tb + k) * 16384 + 13 * 1024 + c0); rgg[k] = *(const u32x4*)(Pall + (size_t)(tb + k) * 16384 + 15 * 1024 + c0); }
    float u[6][8];
#pragma unroll
    for (int k = 0; k < 6; ++k) {
#pragma unroll
      for (int e = 0; e < 4; ++e) { u[k][2 * e] = bf_lo(ra[k][e]) * bf_lo(rb[k][e]); u[k][2 * e + 1] = bf_hi(ra[k][e]) * bf_hi(rb[k][e]); } }
#pragma unroll
    for (int k = 0; k < 4; ++k) {
      float y[8];
#pragma unroll
      for (int e = 0; e < 4; ++e) {
        y[2 * e] = silu(bf_lo(rgg[k][e])) * bf_lo(rbb[k][e]) * (w0[2 * e] * u[k][2 * e] + w1[2 * e] * u[k + 1][2 * e] + w2[2 * e] * u[k + 2][2 * e]);
        y[2 * e + 1] = silu(bf_hi(rgg[k][e])) * bf_hi(rbb[k][e]) * (w0[2 * e + 1] * u[k][2 * e + 1] + w1[2 * e + 1] * u[k + 1][2 * e + 1] + w2[2 * e + 1] * u[k + 2][2 * e + 1]); }
      u32x4 o; o.x = cvtpk(y[0], y[1]); o.y = cvtpk(y[2], y[3]); o.z = cvtpk(y[4], y[5]); o.w = cvtpk(y[6], y[7]);
      *(u32x4*)(Yall + (size_t)(tb + k) * 4096 + 3072 + c0) = o;
    }
  }
}
}
#ifndef PROBE_MASK
#define PROBE_MASK 0
#endif
#ifndef PROBE_RELAUNCH_LO
#define PROBE_RELAUNCH_LO -1
#define PROBE_RELAUNCH_HI -1
#endif
#ifndef PROBE_ULO
#define PROBE_ULO 0
#define PROBE_UHI 100000
#endif
#ifndef MK_N_LAUNCHES
#define MK_N_LAUNCHES 1
#endif
constexpr int NWAVES = 8;
constexpr int N_PHASES = 10;
constexpr int N_LAUNCHES = MK_N_LAUNCHES;

constexpr int DM = 4096, DIN = 16384, MP = 4096, MS = 16384, MTOT = 20480;
constexpr float LN_EPS = 1e-6f;
constexpr size_t O_NAK = 83886080ull, O_NAV = 92274688ull, O_DFK = 100663296ull, O_DFV = 109051904ull, O_ST = 117440512ull;
constexpr size_t MiB = 1ull << 20;
constexpr size_t WS_CTL = 0, CTL_ZERO_BYTES = 32768;
constexpr size_t WS_MOD = 1 * MiB;
constexpr size_t WS_ROPE = 2 * MiB;
constexpr size_t WS_MISC = 3 * MiB;
constexpr size_t WS_WIN = 4 * MiB;
constexpr size_t WS_WOUT = 260 * MiB;
constexpr size_t WS_CACHE = 324 * MiB;
constexpr size_t WS_H = 388 * MiB;
constexpr size_t WS_P = 548 * MiB;
constexpr size_t WS_Y = 1188 * MiB;
constexpr size_t WS_OF = 1348 * MiB;
constexpr size_t WS_DP = 1428 * MiB;
constexpr size_t WS_OF2 = 1492 * MiB;
constexpr size_t WS_X1 = 1572 * MiB;
constexpr size_t WS_DP4 = 1892 * MiB;
constexpr size_t WS_END = 2020 * MiB;
constexpr int CW_Q0 = 64, CW_QM0 = 128, CW_QM1 = 192, CW_BAR = 4096;
constexpr int RING_BYTES = 131072, BIAS_OFF = 131072, WSF_OFF = BIAS_OFF + 2048, MISC_OFF = WSF_OFF + 2048, LDS_BYTES = 147456;
static_assert(att::SHM_ATTN <= (size_t)BIAS_OFF && 2 * att::SHM_K + 4 * att::SHM_V + 8 * 4096 <= (size_t)BIAS_OFF, "attention LDS");

#define GAS __attribute__((address_space(1)))
#define LAS __attribute__((address_space(3)))
typedef unsigned short bf16;
typedef unsigned v4u __attribute__((ext_vector_type(4)));
typedef unsigned v2u __attribute__((ext_vector_type(2)));
typedef float f32x4 __attribute__((ext_vector_type(4)));
typedef short bf16x8 __attribute__((ext_vector_type(8)));
typedef GAS unsigned gu32;
#define RLX_AGENT __ATOMIC_RELAXED, __HIP_MEMORY_SCOPE_AGENT
#define LDS_WAIT() asm volatile("s_waitcnt lgkmcnt(0)" ::: "memory")
#define VM_WAIT() asm volatile("s_waitcnt vmcnt(0)" ::: "memory")
__device__ __forceinline__ unsigned pk2(float lo, float hi) { unsigned r; asm volatile("v_cvt_pk_bf16_f32 %0, %1, %2" : "=v"(r) : "v"(lo), "v"(hi)); return r; }
__device__ __forceinline__ float bflo(unsigned w) { return __uint_as_float(w << 16); }
__device__ __forceinline__ float bfhi(unsigned w) { return __uint_as_float(w & 0xffff0000u); }
__device__ __forceinline__ float siluf(float x) { return x * __builtin_amdgcn_rcpf(1.f + __builtin_amdgcn_exp2f(-1.4426950408889634f * x)); }

__device__ __forceinline__ int lane_id() { int r; asm volatile("v_mbcnt_lo_u32_b32 %0, -1, 0\n\tv_mbcnt_hi_u32_b32 %0, -1, %0" : "=v"(r)); return r; }
#define TIDNOW(wk) ((wk) * 64 + lane_id())
#define XB_TMO      128
#define XB_XCNT(j)  (256  + 64 * (j))
#define XB_XSUB(j)  (1280 + 64 * (j))
#define XB_XGEN(j)  (2304 + 64 * (j))
#define XB_TOP      3328
#define XB_TOPGEN   3392
#define XCD_BAR_WORDS 3456
#define XB_SPIN_CAP (1u << 18)
__device__ __forceinline__ unsigned xb_ld(unsigned* p)              { return __hip_atomic_load(p, __ATOMIC_RELAXED, __HIP_MEMORY_SCOPE_AGENT); }
__device__ __forceinline__ unsigned xb_add(unsigned* p, unsigned v) { return __hip_atomic_fetch_add(p, v, __ATOMIC_RELAXED, __HIP_MEMORY_SCOPE_AGENT); }
__device__ __forceinline__ unsigned xb_xcc_id() { return (unsigned)__builtin_amdgcn_s_getreg((3 << 11) | 20) & 0xFu; }
#define XB_SPIN(cond, bar) do { unsigned _sp = 0; while (cond) { __builtin_amdgcn_s_sleep(1); \
    if ((++_sp & 255u) == 0u) { if (xb_ld(&(bar)[XB_TMO])) break; if (_sp > XB_SPIN_CAP) { atomicAdd(&(bar)[XB_TMO], 1u); break; } } } } while (0)
struct XcdBarrier { unsigned* bar; unsigned x; volatile LAS unsigned* st; int wk; };
__device__ __forceinline__ XcdBarrier xcd_barrier_post(unsigned* bar, volatile LAS unsigned* st) {
    XcdBarrier b; b.bar = bar; b.x = xb_xcc_id(); b.st = st;
    if (threadIdx.x == 0) (void)xb_add(&bar[XB_XCNT(b.x)], 1u);
    return b;
}
__device__ __forceinline__ void xcd_barrier_complete(unsigned* bar, unsigned x, unsigned& nloc, unsigned& nx) {
    const unsigned G = gridDim.x * gridDim.y * gridDim.z;
    unsigned sum, cnt, mine, sp = 0u;
    for (;;) {
        sum = 0u; cnt = 0u; mine = 0u;
#pragma unroll
        for (unsigned j = 0; j < 16; ++j) { const unsigned c = xb_ld(&bar[XB_XCNT(j)]); sum += c; cnt += (c > 0u) ? 1u : 0u; mine = (j == x) ? c : mine; }
        if (sum == G) break;
        __builtin_amdgcn_s_sleep(1);
        if ((++sp & 255u) == 0u) { if (xb_ld(&bar[XB_TMO])) break; if (sp > XB_SPIN_CAP) { atomicAdd(&bar[XB_TMO], 1u); break; } }
    }
    nloc = mine > 0u ? mine : 1u; nx = cnt > 0u ? cnt : 1u;
}
__device__ __forceinline__ void xcd_barrier(const XcdBarrier& b) {
    asm volatile("s_waitcnt vmcnt(0)" ::: "memory");
    __syncthreads();
    if (b.wk == 0 && lane_id() == 0) {
        unsigned bx = b.x; asm volatile("" : "+v"(bx)); bx = __builtin_amdgcn_readfirstlane(bx);
        unsigned* bar = b.bar;
        __builtin_amdgcn_s_waitcnt(0);
        unsigned nloc = b.st[0], nx = b.st[1];
        if (nloc == 0u) { xcd_barrier_complete(bar, bx, nloc, nx); b.st[0] = nloc; b.st[1] = nx; }
        const unsigned old = xb_add(&bar[XB_XSUB(bx)], 1u);
        const unsigned gen = old / nloc;
        if (old + 1u == (gen + 1u) * nloc) {
            __builtin_amdgcn_fence(__ATOMIC_RELEASE, "agent");
            asm volatile("s_waitcnt vmcnt(0)" ::: "memory");
            const unsigned og = xb_add(&bar[XB_TOP], 1u);
            const unsigned tg = og / nx;
            if (og + 1u == (tg + 1u) * nx) xb_add(&bar[XB_TOPGEN], 1u);
            else XB_SPIN(xb_ld(&bar[XB_TOPGEN]) == tg, bar);
            __builtin_amdgcn_fence(__ATOMIC_ACQUIRE, "agent");
            xb_add(&bar[XB_XGEN(bx)], 1u);
            asm volatile("s_waitcnt vmcnt(0)" ::: "memory");
        } else {
            XB_SPIN(xb_ld(&bar[XB_XGEN(bx)]) == gen, bar);
            __builtin_amdgcn_fence(__ATOMIC_ACQUIRE, "agent");
            asm volatile("s_waitcnt vmcnt(0)" ::: "memory");
        }
    }
    __syncthreads();
}

__device__ __forceinline__ float wave_sum(float v) {
    v += att::swz_xor<1>(v); v += att::swz_xor<2>(v); v += att::swz_xor<4>(v); v += att::swz_xor<8>(v); v += att::swz_xor<16>(v);
    return att::sum_xor32(v);
}
__device__ __forceinline__ int next_unit(gu32* ctr, volatile LAS unsigned* slot, int G, int wk) {
    asm volatile("s_waitcnt lgkmcnt(0)" ::: "memory"); __builtin_amdgcn_s_barrier(); asm volatile("" ::: "memory");
    if (wk == 0 && lane_id() == 0) *slot = (unsigned)G + __hip_atomic_fetch_add(ctr, 1u, RLX_AGENT);
    asm volatile("s_waitcnt lgkmcnt(0)" ::: "memory"); __builtin_amdgcn_s_barrier(); asm volatile("" ::: "memory");
    return __builtin_amdgcn_readfirstlane((int)*slot);
}

__device__ __forceinline__ void p0_transpose_item(const float* W, int K, int N, bf16* WT, LAS float* scr, int item, int lane) {
    const int nblk = N / 32, kb = item / nblk, nb = item % nblk, k0 = 64 * kb, n0 = 32 * nb;
    const float sc = (N == 16384 && n0 >= 9216 && n0 < 10240) ? 0.088388347648318440f : 1.f;
    float wv[32];
#pragma unroll
    for (int i = 0; i < 32; ++i) wv[i] = __builtin_nontemporal_load(&W[(size_t)(k0 + 2 * i + (lane >> 5)) * N + n0 + (lane & 31)]);
#pragma unroll
    for (int i = 0; i < 32; ++i) { const int kk = 2 * i + (lane >> 5); scr[kk * 33 + (lane & 31)] = wv[i] * sc; }
    LDS_WAIT(); asm volatile("" ::: "memory");
    const int c = lane & 7;
#pragma unroll
    for (int j = 0; j < 4; ++j) { const int n = (lane >> 3) + 8 * j; const LAS float* s = scr + (8 * c) * 33 + n;
        v4u o; o.x = pk2(s[0 * 33], s[1 * 33]); o.y = pk2(s[2 * 33], s[3 * 33]); o.z = pk2(s[4 * 33], s[5 * 33]); o.w = pk2(s[6 * 33], s[7 * 33]);
        *(GAS v4u*)(WT + (size_t)(n0 + n) * K + k0 + 8 * c) = o; }
    LDS_WAIT(); asm volatile("" ::: "memory");
}

struct Args { const float* in[20]; float* out; unsigned char* ws; int ph_lo, ph_hi; };
struct DArgs { GAS const float* in[20]; GAS float* out; GAS unsigned char* ws; };

constexpr int P0_GEMV = 96, P0_MISC = 1, P0_TR = 640, P0_CV = 1024, P0_UNITS = P0_GEMV + P0_MISC + P0_TR + P0_CV;
constexpr int DEF_GEMV = 96, DEF_TR = 640, DEF_UNITS = DEF_GEMV + DEF_TR;
__device__ __forceinline__ void p0_gemv_unit(const DArgs& a, LAS unsigned char* lds, int uidx, const int tid) {
    const int l = uidx / 96, cb = uidx % 96, col0 = cb * 128, tx = tid & 31, kg = tid >> 5;
    const float* c = ((const float*)a.in[7]); const float* cctx = ((const float*)a.in[8]); const float* wada = ((const float*)a.in[9]) + (size_t)l * 4096 * 12288; const float* bada = ((const float*)a.in[10]) + (size_t)l * 12288;
    float* mod = (float*)(((unsigned char*)a.ws) + WS_MOD) + (size_t)l * 9 * 12288;
    LAS float* sc = (LAS float*)lds;
    float acc[9][4];
#pragma unroll
    for (int v = 0; v < 9; ++v)
#pragma unroll
        for (int j = 0; j < 4; ++j) acc[v][j] = 0.f;
    for (int half = 0; half < 2; ++half) {
        __syncthreads();
        for (int idx = tid; idx < 2048 * 9; idx += 512) { const int k = idx / 9, v = idx - 9 * k; const float x = (v < 8) ? c[v * 4096 + half * 2048 + k] : cctx[half * 2048 + k]; sc[k * 12 + v] = siluf(x); }
        __syncthreads();
        const float* wp = wada + (size_t)(half * 2048 + kg * 128) * 12288 + col0 + tx * 4;
#pragma unroll 1
        for (int kk0 = 0; kk0 < 128; kk0 += 16) {
            f32x4 wv[16];
#pragma unroll
            for (int i = 0; i < 16; ++i) wv[i] = __builtin_nontemporal_load((const f32x4*)(wp + (size_t)(kk0 + i) * 12288));
            __builtin_amdgcn_sched_barrier(0);
#pragma unroll
            for (int i = 0; i < 16; ++i) { const f32x4 w = wv[i];
                const LAS float* sp = sc + (kg * 128 + kk0 + i) * 12;
                const f32x4 s0 = *(const LAS f32x4*)sp, s1 = *(const LAS f32x4*)(sp + 4); const float s8 = sp[8];
#pragma unroll
                for (int j = 0; j < 4; ++j) { acc[0][j] += s0[0] * w[j]; acc[1][j] += s0[1] * w[j]; acc[2][j] += s0[2] * w[j]; acc[3][j] += s0[3] * w[j];
                    acc[4][j] += s1[0] * w[j]; acc[5][j] += s1[1] * w[j]; acc[6][j] += s1[2] * w[j]; acc[7][j] += s1[3] * w[j]; acc[8][j] += s8 * w[j]; } }
        }
    }
    __syncthreads();
    LAS float* red = (LAS float*)lds;
#pragma unroll
    for (int v = 0; v < 9; ++v)
#pragma unroll
        for (int j = 0; j < 4; ++j) red[(kg * 9 + v) * 128 + tx * 4 + j] = acc[v][j];
    __syncthreads();
    for (int o = tid; o < 9 * 128; o += 512) { const int v = o >> 7, cc = o & 127; float s = bada[col0 + cc];
#pragma unroll
        for (int g = 0; g < 16; ++g) s += red[(g * 9 + v) * 128 + cc];
        mod[(size_t)v * 12288 + col0 + cc] = s; }
}
__device__ __forceinline__ void p0_misc_unit(const DArgs& a, const int tid) {
    float* rope = (float*)(((unsigned char*)a.ws) + WS_ROPE);
    for (int e = tid; e < 64 * 32; e += 512) { const int pos = e >> 5, f = e & 31;
        const float inv = __builtin_amdgcn_exp2f(-(float)f * (13.287712379549449f / 32.f));
        const float ang = (float)pos * inv; const float rev = ang * 0.15915494309189535f;
        const float fr = rev - floorf(rev);
        rope[2 * e] = __builtin_amdgcn_cosf(fr); rope[2 * e + 1] = __builtin_amdgcn_sinf(fr); }
    if (tid < 2) { const float* lf = ((const float*)a.in[16]) + (size_t)tid * 4 * 128; float s1 = 0.f, s2 = 0.f;
        for (int d = 0; d < 128; ++d) { s1 += lf[d] * lf[128 + d]; s2 += lf[256 + d] * lf[384 + d]; }
        const float lam_init = 0.8f - 0.6f * expf(-0.3f * (float)tid);
        ((float*)(((unsigned char*)a.ws) + WS_MISC))[tid] = expf(s1) - expf(s2) + lam_init; }
}
__device__ __forceinline__ void p0_tr_unit(const DArgs& a, LAS unsigned char* lds, int tu, const int tid) {
    const int wave = __builtin_amdgcn_readfirstlane(tid >> 6), lane = tid & 63;
    LAS float* scr = (LAS float*)(lds + wave * 16384);
    constexpr int I_IN = 64 * 512, I_OUT = 64 * 128, I_L = I_IN + I_OUT;
#pragma unroll 1
    for (int s = 0; s < 8; ++s) { int it = tu * 64 + wave * 8 + s; const int l = it / I_L; it -= l * I_L;
        if (it < I_IN) p0_transpose_item(((const float*)a.in[11]) + (size_t)l * 4096 * 16384, 4096, 16384, (bf16*)(((unsigned char*)a.ws) + WS_WIN) + (size_t)l * 16384 * 4096, scr, it, lane);
        else p0_transpose_item(((const float*)a.in[12]) + (size_t)l * 4096 * 4096, 4096, 4096, (bf16*)(((unsigned char*)a.ws) + WS_WOUT) + (size_t)l * 4096 * 4096, scr, it - I_IN, lane); }
}
__device__ __forceinline__ void p0_cv_unit(const DArgs& a, int cu, const int tid) {
    const size_t idx0 = (size_t)cu * 4096 + tid; const int arr = (int)(idx0 >> 20);
    const float* src = (arr == 0 ? ((const float*)a.in[2]) : arr == 1 ? ((const float*)a.in[3]) : arr == 2 ? ((const float*)a.in[4]) : ((const float*)a.in[5]));
    bf16* dst = (bf16*)(((unsigned char*)a.ws) + WS_CACHE) + (size_t)arr * 8388608;
    f32x4 xv[16];
#pragma unroll
    for (int s = 0; s < 8; ++s) { const size_t e = ((idx0 + 512 * s) & 1048575u) * 8; xv[2 * s] = __builtin_nontemporal_load((const f32x4*)(src + e)); xv[2 * s + 1] = __builtin_nontemporal_load((const f32x4*)(src + e + 4)); }
    __builtin_amdgcn_sched_barrier(0);
#pragma unroll
    for (int s = 0; s < 8; ++s) { const size_t e = ((idx0 + 512 * s) & 1048575u) * 8; const f32x4 x0 = xv[2 * s], x1 = xv[2 * s + 1];
        v4u o; o.x = pk2(x0[0], x0[1]); o.y = pk2(x0[2], x0[3]); o.z = pk2(x1[0], x1[1]); o.w = pk2(x1[2], x1[3]);
        __builtin_nontemporal_store(o, (v4u*)(dst + e)); }
}

template <bool XBF> __device__ __forceinline__ void ln_phase(const DArgs& a, LAS unsigned char* lds, int mode, int lprev, bool hnext, int lnext, const int tid) {
    const int wave = __builtin_amdgcn_readfirstlane(tid >> 6), G = gridDim.x; int lane = tid & 63;
    bf16* H = (bf16*)(((unsigned char*)a.ws) + WS_H);
    const float* modn = (const float*)(((unsigned char*)a.ws) + WS_MOD) + (size_t)lnext * 9 * 12288;
    const int rpw = (MTOT + G - 1) / G, r0 = blockIdx.x * rpw, r1 = (r0 + rpw < MTOT) ? r0 + rpw : MTOT;
    if (r0 >= MTOT) return;
    const int vecA = r0 < MP ? 8 : ((r0 - MP) >> 11), vecB = (r1 - 1) < MP ? 8 : ((r1 - 1 - MP) >> 11);
    LAS f32x4* LG = (LAS f32x4*)lds; LAS f32x4* LB = LG + 1024; LAS f32x4* LSH = LG + 2048; LAS f32x4* LSC = LG + 3072;
    __syncthreads();
    for (int i = tid; i < 1024; i += 512) {
        if (mode == 1) { LG[i] = *(const f32x4*)(((const float*)a.in[13]) + (size_t)lprev * DM + 4 * i); LB[i] = *(const f32x4*)(((const float*)a.in[14]) + (size_t)lprev * DM + 4 * i); }
        if (mode == 0 || hnext) {
            LSH[i] = *(const f32x4*)(modn + (size_t)vecA * 12288 + 4 * i); LSC[i] = *(const f32x4*)(modn + (size_t)vecA * 12288 + 4096 + 4 * i);
            LSH[4096 + i] = *(const f32x4*)(modn + (size_t)vecB * 12288 + 4 * i); LSC[4096 + i] = *(const f32x4*)(modn + (size_t)vecB * 12288 + 4096 + 4 * i); } }
    __syncthreads();
    const int m0 = r0 + wave;
    f32x4 nx[16]; v2u ny[16];
    constexpr bool xbf = XBF;
#define LN_SRC(m) ((m) < MP ? ((const float*)a.in[0]) + (size_t)(m) * DM : ((const float*)a.in[1]) + (size_t)((m) - MP) * DM)
#define LN_LOAD(m) do { if (xbf) { const bf16* q_ = (const bf16*)(((unsigned char*)a.ws) + WS_X1) + (size_t)(m) * DM + 4 * lane; _Pragma("unroll") for (int j = 0; j < 16; ++j) { const v2u t_ = __builtin_nontemporal_load((const v2u*)(q_ + 256 * j)); nx[j][0] = __uint_as_float(t_.x); nx[j][1] = __uint_as_float(t_.y); } } \
        else { const float* s_ = LN_SRC(m) + 4 * lane; _Pragma("unroll") for (int j = 0; j < 16; ++j) nx[j] = __builtin_nontemporal_load((const f32x4*)(s_ + 256 * j)); } \
        if (mode == 1) { const bf16* y_ = H + (size_t)(m) * DM + 4 * lane; _Pragma("unroll") for (int j = 0; j < 16; ++j) ny[j] = __builtin_nontemporal_load((const v2u*)(y_ + 256 * j)); } } while (0)
    if (m0 < r1) LN_LOAD(m0);
    for (int m = m0; m < r1; m += NWAVES) {
        asm volatile("" : "+v"(lane));
        f32x4 v[16]; float s = 0.f;
#pragma unroll
        for (int j = 0; j < 16; ++j) { v[j] = xbf ? (f32x4){bflo(__float_as_uint(nx[j][0])), bfhi(__float_as_uint(nx[j][0])), bflo(__float_as_uint(nx[j][1])), bfhi(__float_as_uint(nx[j][1]))} : nx[j];
            if (mode == 1) { v[j] = v[j] * 1.41421356237f + (f32x4){bflo(ny[j].x), bfhi(ny[j].x), bflo(ny[j].y), bfhi(ny[j].y)}; }
            s += (v[j][0] + v[j][1]) + (v[j][2] + v[j][3]); }
        if (m + NWAVES < r1) LN_LOAD(m + NWAVES);
        float mean = wave_sum(s) * (1.f / DM); float s2 = 0.f;
#pragma unroll
        for (int j = 0; j < 16; ++j) { v[j] = v[j] - mean; s2 += (v[j][0] * v[j][0] + v[j][1] * v[j][1]) + (v[j][2] * v[j][2] + v[j][3] * v[j][3]); }
        float rstd = 1.f / sqrtf(wave_sum(s2) * (1.f / DM) + LN_EPS);
        if (mode == 1) {
            float* dst = ((float*)a.out) + (size_t)m * DM; bf16* dstb = (bf16*)(((unsigned char*)a.ws) + WS_X1) + (size_t)m * DM;
            s = 0.f;
#pragma unroll
            for (int j = 0; j < 16; ++j) { const f32x4 gg = LG[lane + 64 * j], bb = LB[lane + 64 * j];
                v[j] = v[j] * rstd * gg + bb;
                if (hnext) { v2u o; o.x = pk2(v[j][0], v[j][1]); o.y = pk2(v[j][2], v[j][3]); __builtin_nontemporal_store(o, (v2u*)(dstb + 4 * lane + 256 * j)); }
                else __builtin_nontemporal_store(v[j], (f32x4*)(dst + 4 * lane + 256 * j));
                s += (v[j][0] + v[j][1]) + (v[j][2] + v[j][3]);
                if ((j & 3) == 3) asm volatile("" ::: "memory"); }
            if (!hnext) continue;
            mean = wave_sum(s) * (1.f / DM); s2 = 0.f;
#pragma unroll
            for (int j = 0; j < 16; ++j) { v[j] = v[j] - mean; s2 += (v[j][0] * v[j][0] + v[j][1] * v[j][1]) + (v[j][2] * v[j][2] + v[j][3] * v[j][3]); }
            rstd = 1.f / sqrtf(wave_sum(s2) * (1.f / DM) + LN_EPS);
        }
        const int vec = m < MP ? 8 : ((m - MP) >> 11);
        const int so = (vec == vecA) ? 0 : 4096;
        bf16* hrow = H + (size_t)m * DM;
#pragma unroll
        for (int j = 0; j < 16; ++j) { const f32x4 ss = LSC[so + lane + 64 * j], hh = LSH[so + lane + 64 * j];
            const f32x4 y = v[j] * rstd * (ss + 1.f) + hh;
            v2u o; o.x = pk2(y[0], y[1]); o.y = pk2(y[2], y[3]);
            *(v2u*)(hrow + 4 * lane + 256 * j) = o;
            if ((j & 3) == 3) asm volatile("" ::: "memory"); }
    }
#undef LN_SRC
#undef LN_LOAD
}

__device__ __forceinline__ void rf_phase(const DArgs& a, int l, const int tid) {
    const int wave = __builtin_amdgcn_readfirstlane(tid >> 6), lane = tid & 63, G = gridDim.x;
    for (int it = blockIdx.x * NWAVES + wave; it < MP * 8; it += G * NWAVES) { const int m = it >> 3, part = it & 7, grp = part >> 1, hf = part & 1;
        const int gcol = (grp == 0 ? 1024 : grp == 1 ? 2048 : grp == 2 ? 5120 : 6144) + hf * 512 + 8 * lane;
        const v4u w = *(const v4u*)((const bf16*)(((unsigned char*)a.ws) + WS_P) + (size_t)m * DIN + gcol);
        float* dst = ((float*)a.out) + O_NAK + (size_t)grp * 8388608 + ((size_t)((m >> 8) * 2 + l) * 256 + (m & 255)) * 1024 + hf * 512 + 8 * lane;
        *(f32x4*)dst = (f32x4){bflo(w.x), bfhi(w.x), bflo(w.y), bfhi(w.y)}; *(f32x4*)(dst + 4) = (f32x4){bflo(w.z), bfhi(w.z), bflo(w.w), bfhi(w.w)}; }
    const float* OFf = (const float*)(((unsigned char*)a.ws) + WS_OF); const float* OFb = (const float*)(((unsigned char*)a.ws) + WS_OF2);
    const bf16* P = (const bf16*)(((unsigned char*)a.ws) + WS_P); bf16* Y = (bf16*)(((unsigned char*)a.ws) + WS_Y);
    for (int m = blockIdx.x * NWAVES + wave; m < MTOT; m += G * NWAVES) {
        const float* pf = OFf + (size_t)m * 1024 + 16 * lane; const float* pb = OFb + (size_t)m * 1024 + 16 * lane;
        f32x4 x[4]; float s = 0.f;
#pragma unroll
        for (int k = 0; k < 4; ++k) { x[k] = *(const f32x4*)(pf + 4 * k) + *(const f32x4*)(pb + 4 * k); s += (x[k][0] + x[k][1]) + (x[k][2] + x[k][3]); }
        const v4u g0 = *(const v4u*)(P + (size_t)m * DIN + 11264 + 16 * lane), g1 = *(const v4u*)(P + (size_t)m * DIN + 11264 + 16 * lane + 8);
        s += __shfl_xor(s, 1); s += __shfl_xor(s, 2); s += __shfl_xor(s, 4);
        const float mean = s * (1.f / 128.f); float vs = 0.f;
#pragma unroll
        for (int k = 0; k < 4; ++k) { x[k] = x[k] - mean; vs += (x[k][0] * x[k][0] + x[k][1] * x[k][1]) + (x[k][2] * x[k][2] + x[k][3] * x[k][3]); }
        vs += __shfl_xor(vs, 1); vs += __shfl_xor(vs, 2); vs += __shfl_xor(vs, 4);
        const float rstd = 1.f / sqrtf(vs * (1.f / 128.f) + LN_EPS);
        v4u o0, o1;
        o0.x = pk2(x[0][0] * rstd * siluf(bflo(g0.x)), x[0][1] * rstd * siluf(bfhi(g0.x))); o0.y = pk2(x[0][2] * rstd * siluf(bflo(g0.y)), x[0][3] * rstd * siluf(bfhi(g0.y)));
        o0.z = pk2(x[1][0] * rstd * siluf(bflo(g0.z)), x[1][1] * rstd * siluf(bfhi(g0.z))); o0.w = pk2(x[1][2] * rstd * siluf(bflo(g0.w)), x[1][3] * rstd * siluf(bfhi(g0.w)));
        o1.x = pk2(x[2][0] * rstd * siluf(bflo(g1.x)), x[2][1] * rstd * siluf(bfhi(g1.x))); o1.y = pk2(x[2][2] * rstd * siluf(bflo(g1.y)), x[2][3] * rstd * siluf(bfhi(g1.y)));
        o1.z = pk2(x[3][0] * rstd * siluf(bflo(g1.z)), x[3][1] * rstd * siluf(bfhi(g1.z))); o1.w = pk2(x[3][2] * rstd * siluf(bflo(g1.w)), x[3][3] * rstd * siluf(bfhi(g1.w)));
        *(v4u*)(Y + (size_t)m * DM + 2048 + 16 * lane) = o0; *(v4u*)(Y + (size_t)m * DM + 2048 + 16 * lane + 8) = o1;
    }
}

constexpr int MU_CS = 64, MU_BS = 256, MU_AS = 512, MU_BP = 64, MU_CP = 128, MU_AP = 128, MU_CV = 320, MU_CO = 64;
constexpr int MO_CS = 0, MO_BS = MO_CS + MU_CS, MO_AS = MO_BS + MU_BS, MO_BP = MO_AS + MU_AS, MO_CP = MO_BP + MU_BP, MO_AP = MO_CP + MU_CP, MO_CV = MO_AP + MU_AP, MO_CO = MO_CV + MU_CV, MU_TOTAL = MO_CO + MU_CO;

__device__ __forceinline__ void mixer_phase(const DArgs& a, unsigned char* ldsg, int l, const int wid, int qsel = 0) {
    const int G = gridDim.x;
    LAS unsigned char* lds = (LAS unsigned char*)ldsg;
    volatile LAS unsigned* slot = (volatile LAS unsigned*)(lds + MISC_OFF);
    LAS float* biasS = (LAS float*)(lds + BIAS_OFF);
    gu32* ctr = (gu32*)(((unsigned char*)a.ws) + WS_CTL) + (l ? CW_QM1 : CW_QM0) + qsel * 256;
    const bf16* P = (const bf16*)(((unsigned char*)a.ws) + WS_P); bf16* Y = (bf16*)(((unsigned char*)a.ws) + WS_Y);
    const bf16* cNAK = (const bf16*)(((unsigned char*)a.ws) + WS_CACHE); const bf16* cNAV = cNAK + 8388608; const bf16* cDFK = cNAV + 8388608; const bf16* cDFV = cDFK + 8388608;
    const float lam = ((const float*)(((unsigned char*)a.ws) + WS_MISC))[l];
    const float one_m_lam_init = __uint_as_float(__builtin_amdgcn_readfirstlane(__float_as_uint(l ? (1.f - 0.35550906759f) : 0.8f)));
#define UNIT_HEAD(q) ((G != 256) ? (q) : ((q) < 64 ? (q) : ((q) < 256 ? MO_BS + ((q) & 7) * 32 + (((q) - 64) >> 3) : MO_BS + (((q) - 256) & 7) * 32 + 24 + (((q) - 256) >> 3))))
    constexpr int ILV = (DEF_UNITS / 2) * 5;
    const int qtotal = MU_TOTAL + (l == 0 ? DEF_UNITS : 0);
#define UNIT_OF(q) unit_of_(q, G, l)
    auto unit_of_ = [](int q, int G, int l) -> int {
        if (q < 320) return UNIT_HEAD(q);
        if (l != 0) return q;
        const int qq = q - 320;
        if (qq >= ILV) return 320 + (ILV / 5) * 3 + (qq - ILV);
        const int k = qq / 5, r = qq - 5 * k;
        if (r == 1 || r == 3) return MU_TOTAL + 2 * k + (r == 3 ? 1 : 0);
        return 320 + 3 * k + (r == 0 ? 0 : (r == 2 ? 1 : 2));
    };
    int qpos = blockIdx.x; int u = UNIT_OF(qpos);
    while (qpos < qtotal) {
        if (qsel && (u < PROBE_ULO || u >= PROBE_UHI)) { qpos = next_unit(ctr, slot, G, wid); u = UNIT_OF(qpos); continue; }
        int tid = TIDNOW(wid); asm volatile("" : "+v"(tid));
        const int lane = tid & 63;
        if (u >= MU_TOTAL) {
            const int d = u - MU_TOTAL;
            if (d < DEF_GEMV) p0_gemv_unit(a, lds, P0_GEMV + d, tid); else p0_tr_unit(a, lds, P0_TR + (d - DEF_GEMV), tid);
        } else
#ifndef NO_ATT
        if ((u >= MO_BS && u < MO_CP) || (u >= MO_AP && u < MO_CV)) {
            int kind, b, h, qb;
            if (u < MO_AS) { kind = 0; const int x = u - MO_BS; b = x >> 5; h = (x >> 3) & 3; qb = x & 7; }
            else if (u < MO_BP) { kind = 1; const int x = u - MO_AS; b = x >> 6; h = (x >> 3) & 7; qb = x & 7; }
            else if (u < MO_CP) { kind = 2; const int x = u - MO_BP; b = x >> 2; h = x & 3; qb = 0; }
            else { kind = 3; const int x = u - MO_AP; b = x >> 3; h = x & 7; qb = 0; }
            const bool isB = (kind == 0 || kind == 2), isS = (kind < 2);
            const int seq0 = isS ? MP + b * 2048 : b * 256;
            const int row0 = seq0 + qb * 256;
            att::Run R; R.ldq = DIN; R.ld0 = 1024; R.ld1 = DIN; R.nt0 = isS ? 8 : 0; R.na = (kind == 1); R.rq0 = qb * 4; R.rlo = 0;
#ifdef PROBE_DMA0
            R.probe = qsel; R.Kz = (const bf16*)(((unsigned char*)a.ws) + WS_OF2);
#endif
            const size_t coff = ((size_t)(b * 2 + l) * 512) * 1024;
            if (kind == 1) {
                int lo = qb * 4 - 4; lo = lo < 0 ? 0 : (lo > 24 ? 24 : lo); int hi4 = qb * 4 + 3 - 4; hi4 = hi4 < 0 ? 0 : (hi4 > 24 ? 24 : hi4); hi4 += 7;
                int nloc = hi4 - lo + 1; nloc += (nloc & 1);
                R.rlo = lo; R.NT = 8 + nloc;
                R.Q = P + (size_t)row0 * DIN + h * 128;
                R.K0 = cNAK + coff + h * 128; R.V0 = cNAV + coff + h * 128;
                R.K1 = P + (size_t)(seq0 + lo * 64) * DIN + 1024 + h * 128; R.V1 = P + (size_t)(seq0 + lo * 64) * DIN + 2048 + h * 128;
                __syncthreads();
                for (int i = tid; i < 15 * 32; i += 512) { const int dr = i >> 5, dc = i & 31; biasS[i] = dc < 31 ? ((const float*)a.in[15])[((size_t)(l * 8 + h) * 15 + dr) * 31 + dc] * (1.f / att::SCALE) : 0.f; }
                __syncthreads();
            } else if (kind == 3) {
                R.NT = 4; R.Q = P + (size_t)row0 * DIN + h * 128; R.K0 = R.Q; R.V0 = R.Q;
                R.K1 = P + (size_t)seq0 * DIN + 1024 + h * 128; R.V1 = P + (size_t)seq0 * DIN + 2048 + h * 128;
            } else {
                R.NT = isS ? 40 : 4;
            }
            f32x4* pk4 = (f32x4*)(((unsigned char*)a.ws) + WS_DP4) + (size_t)blockIdx.x * 32768;
            float* T = (float*)(ldsg + wid * 16384);
            if (!isB) {
                att::f32x16 o[4];
                att::attn_run(R, (char*)ldsg, (float*)(ldsg + WSF_OFF), biasS, o, tid);
                int t2 = TIDNOW(wid); asm volatile("" : "+v"(t2)); const int lz = t2 & 63;
                att::store_tile(o, T, lz, P + (size_t)(row0 + 32 * wid) * DIN + 3072 + h * 128, DIN, Y + (size_t)(row0 + 32 * wid) * DM + h * 128, DM, nullptr);
            } else {
                for (int t = 0; t < 2; ++t) {
                    R.Q = P + (size_t)row0 * DIN + 4096 + h * 256 + t * 128;
                    R.K0 = cDFK + coff + h * 256 + t * 128; R.V0 = cDFV + coff + h * 256;
                    R.K1 = P + (size_t)seq0 * DIN + 5120 + h * 256 + t * 128; R.V1 = P + (size_t)seq0 * DIN + 6144 + h * 256;
                    att::f32x16 o[4], o2[4];
                    att::attn_run_w(R, (char*)ldsg, (float*)(ldsg + WSF_OFF), o, o2, tid);
                    int t2 = TIDNOW(wid); asm volatile("" : "+v"(t2));
                    const unsigned ub = (unsigned)t2 + (unsigned)t * 16384u;
#pragma unroll
                    for (int d0 = 0; d0 < 4; ++d0) {
#pragma unroll
                        for (int g = 0; g < 4; ++g) pk4[ub + (unsigned)((d0 * 4 + g) * 512)] = (f32x4){o[d0][4 * g], o[d0][4 * g + 1], o[d0][4 * g + 2], o[d0][4 * g + 3]};
                        asm volatile("" ::: "memory"); }
#pragma unroll
                    for (int d0 = 0; d0 < 4; ++d0) {
#pragma unroll
                        for (int g = 0; g < 4; ++g) pk4[ub + 8192u + (unsigned)((d0 * 4 + g) * 512)] = (f32x4){o2[d0][4 * g], o2[d0][4 * g + 1], o2[d0][4 * g + 2], o2[d0][4 * g + 3]};
                        asm volatile("" ::: "memory"); }
                }
                int t3 = TIDNOW(wid); asm volatile("" : "+v"(t3));
                const int lz = t3 & 63; const unsigned utid = (unsigned)t3;
                float* rsL = (float*)(ldsg + WSF_OFF) + wid * 64;
                const float* sub = ((const float*)a.in[17]) + (size_t)l * 256;
                const bf16* gb = P + (size_t)(row0 + 32 * wid) * DIN + 7168 + h * 256; bf16* yb = Y + (size_t)(row0 + 32 * wid) * DM + 1024 + h * 256;
#ifdef PROBE_DMA0
                long ldy_ = DM; if (qsel) { yb = (bf16*)(((unsigned char*)a.ws) + WS_DP) + (size_t)(blockIdx.x * 8 + wid) * 8192; ldy_ = 256; }
#else
                constexpr long ldy_ = DM;
#endif
#define PARK_LD16(slot, d0) ({ const f32x4 a_ = pk4[(slot) + (unsigned)(((d0) * 4 + 0) * 512) + utid], b_ = pk4[(slot) + (unsigned)(((d0) * 4 + 1) * 512) + utid], \
                                 c_ = pk4[(slot) + (unsigned)(((d0) * 4 + 2) * 512) + utid], d_ = pk4[(slot) + (unsigned)(((d0) * 4 + 3) * 512) + utid]; \
                                 (att::f32x16){a_[0], a_[1], a_[2], a_[3], b_[0], b_[1], b_[2], b_[3], c_[0], c_[1], c_[2], c_[3], d_[0], d_[1], d_[2], d_[3]}; })
                att::f32x16 ssv = {};
                { att::f32x16 dl[4];
#pragma unroll
                  for (int d0 = 0; d0 < 4; ++d0) { const att::f32x16 va = PARK_LD16(0u, d0), vc = PARK_LD16(16384u, d0); dl[d0] = va - vc * lam; ssv += dl[d0] * dl[d0]; asm volatile("" ::: "memory"); }
                  att::tile_put(dl, T, lz); }
                att::f32x16 dh[4];
#pragma unroll
                for (int d0 = 0; d0 < 4; ++d0) { const att::f32x16 va = PARK_LD16(8192u, d0), vc = PARK_LD16(24576u, d0); dh[d0] = va - vc * lam; ssv += dh[d0] * dh[d0]; asm volatile("" ::: "memory"); }
#undef PARK_LD16
#pragma unroll
                for (int r = 0; r < 16; ++r) { float ss = ssv[r];
                    ss += att::swz_xor<1>(ss); ss += att::swz_xor<2>(ss); ss += att::swz_xor<4>(ss); ss += att::swz_xor<8>(ss); ss += att::swz_xor<16>(ss);
                    const float rs = one_m_lam_init / sqrtf(ss * (1.f / 256.f) + LN_EPS);
                    if ((lz & 31) == 0) rsL[att::crow(r, lz >> 5)] = rs; }
                att::tile_emit(T, lz, gb, DIN, yb, ldy_, sub, rsL);
                att::tile_put(dh, T, lz);
                att::tile_emit(T, lz, gb + 128, DIN, yb + 128, ldy_, sub + 128, rsL);
            }
        } else
#endif
#ifndef NO_RET
        if (u < MO_CV) {
            const bool isS = (u < MO_BS); const int x = isS ? u - MO_CS : u - MO_CP; const int b = x >> 3, h = x & 7;
            const int seq0 = isS ? MP + b * 2048 : b * 256;
#pragma unroll 1
            for (int dir = 0; dir < 2; ++dir) {
                const float xx = ((const float*)a.in[18])[(size_t)l * 16 + dir * 8 + h]; const float yv = expf(-xx);
                const float ln1p = (yv < 1e-3f) ? yv * (1.f - yv * (0.5f - yv * (1.f / 3.f))) : logf(1.f + yv);
                const float lg2 = -ln1p * 1.4426950408889634f;
                const float* s0 = isS ? ((const float*)a.in[6]) + ((size_t)((b * 2 + l) * 2 + dir) * 8 + h) * 16384 : nullptr;
                float* sout = isS ? nullptr : ((float*)a.out) + O_ST + ((size_t)((b * 2 + l) * 2 + dir) * 8 + h) * 16384;
                int td = TIDNOW(wid); asm volatile("" : "+v"(td));
                ret::ret_unit((char*)ldsg, P + (size_t)seq0 * DIN, (float*)(((unsigned char*)a.ws) + WS_OF) + (size_t)seq0 * 1024, dir ? Y + (size_t)seq0 * DM : nullptr, s0, sout, isS ? 16 : 2, h, dir, lg2, td);
            }
        } else
#endif
        if (u < MO_CO) {
            ret::conv_unit(P, Y, ((const float*)a.in[19]) + (size_t)l * 3072, (u - MO_CV) * 64, tid);
        } else {
            const int rbase = (u - MO_CO) * 64;
#pragma unroll 1
            for (int it0 = wid; it0 < 64 * 8; it0 += NWAVES * 8) {
                v4u w[8];
#pragma unroll
                for (int j = 0; j < 8; ++j) { const int it = it0 + j * NWAVES, m = rbase + (it >> 3), part = it & 7, grp = part >> 1, hf = part & 1;
                    const int gcol = (grp == 0 ? 1024 : grp == 1 ? 2048 : grp == 2 ? 5120 : 6144) + hf * 512 + 8 * lane;
                    w[j] = *(const v4u*)(P + (size_t)m * DIN + gcol); }
#pragma unroll
                for (int j = 0; j < 8; ++j) { const int it = it0 + j * NWAVES, m = rbase + (it >> 3), part = it & 7, grp = part >> 1, hf = part & 1;
                    float* dst = ((float*)a.out) + O_NAK + (size_t)grp * 8388608 + ((size_t)((m >> 8) * 2 + l) * 256 + (m & 255)) * 1024 + hf * 512 + 8 * lane;
                    __builtin_nontemporal_store((f32x4){bflo(w[j].x), bfhi(w[j].x), bflo(w[j].y), bfhi(w[j].y)}, (f32x4*)dst); __builtin_nontemporal_store((f32x4){bflo(w[j].z), bfhi(w[j].z), bflo(w[j].w), bfhi(w[j].w)}, (f32x4*)(dst + 4)); }
            }
        }
        qpos = next_unit(ctr, slot, G, wid); u = UNIT_OF(qpos);
    }
#undef UNIT_OF
#undef UNIT_HEAD
}

__global__ void __launch_bounds__(NWAVES * 64, 2) mk_fwd(Args args) {
    extern __shared__ __attribute__((aligned(16))) unsigned char lds[];
    LAS unsigned char* L = (LAS unsigned char*)lds;
    volatile LAS unsigned* MISC = (volatile LAS unsigned*)(L + MISC_OFF);
    const int tid = threadIdx.x, G = gridDim.x;
    const int wk = __builtin_amdgcn_readfirstlane(tid >> 6);
    for (int u = tid; u < (LDS_BYTES - MISC_OFF) / 4; u += NWAVES * 64) MISC[u] = 0u;
    __syncthreads();
    gu32* ctl = (gu32*)((GAS unsigned char*)args.ws + WS_CTL);
    XcdBarrier bar; bar.bar = (unsigned*)ctl + CW_BAR; bar.x = 0; bar.st = nullptr; bar.wk = wk;
    if (N_LAUNCHES == 1) { bar = xcd_barrier_post((unsigned*)ctl + CW_BAR, MISC + 8); bar.wk = wk; }
#define GRID_BAR() do { if (N_LAUNCHES == 1) xcd_barrier(bar); } while (0)
    const int lo = args.ph_lo, hi = args.ph_hi;
#define ARGS_HERE(name) DArgs name; { const Args* p_ = (const Args*)__builtin_amdgcn_kernarg_segment_ptr(); asm volatile("" : "+s"(p_)); \
        _Pragma("unroll") for (int i_ = 0; i_ < 20; ++i_) name.in[i_] = (GAS const float*)p_->in[i_]; \
        name.out = (GAS float*)p_->out; name.ws = (GAS unsigned char*)p_->ws; }
#ifndef PH_MASK
#define PH_MASK 0xfff
#endif
#define ARGS_PLAIN(name) DArgs name; { _Pragma("unroll") for (int i_ = 0; i_ < 20; ++i_) name.in[i_] = (GAS const float*)args.in[i_]; name.out = (GAS float*)args.out; name.ws = (GAS unsigned char*)args.ws; }
#define IN(k) (((PH_MASK >> ((k) > 5 ? (k) - 4 : (k))) & 1) && ((N_LAUNCHES == 1 && PROBE_RELAUNCH_LO < 0) || (lo <= (k) && (k) < hi)))
#define BOTH(k) (IN(k) && IN((k) + 1))
    ARGS_PLAIN(da);

    if (IN(0)) {
        int u = blockIdx.x;
        while (u < P0_UNITS) {
            const int tu_ = TIDNOW(wk);
            if (u < P0_GEMV) p0_gemv_unit(da, L, u, tu_);
            else if (u < P0_GEMV + P0_MISC) p0_misc_unit(da, tu_);
            else if (u < P0_GEMV + P0_MISC + P0_TR) p0_tr_unit(da, L, u - (P0_GEMV + P0_MISC), tu_);
            else p0_cv_unit(da, u - (P0_GEMV + P0_MISC + P0_TR), tu_);
            u = next_unit(ctl + CW_Q0, MISC + 4, G, wk);
        }
        if (PROBE_MASK & 1) { GRID_BAR(); u = blockIdx.x;
            while (u < P0_UNITS) {
                const int tu_ = TIDNOW(wk);
                if (u < P0_GEMV) p0_gemv_unit(da, L, u, tu_);
                else if (u < P0_GEMV + P0_MISC) p0_misc_unit(da, tu_);
                else if (u < P0_GEMV + P0_MISC + P0_TR) p0_tr_unit(da, L, u - (P0_GEMV + P0_MISC), tu_);
                else p0_cv_unit(da, u - (P0_GEMV + P0_MISC + P0_TR), tu_);
                u = next_unit(ctl + CW_Q0 + 256, MISC + 4, G, wk);
            } }
        if (BOTH(0)) GRID_BAR();
    }
    if (IN(1)) { int tp = TIDNOW(wk); asm volatile("" : "+v"(tp)); ln_phase<false>(da, L, 0, 0, true, 0, tp); if (BOTH(1)) GRID_BAR(); }

#pragma unroll 1
    for (int l = 0; l < 2; ++l) {
        const int pb = 2 + 4 * l;
        if (IN(pb)) {

            pg8::Gemm g{(const bf16*)((unsigned char*)da.ws + WS_H), (const bf16*)((unsigned char*)da.ws + WS_WIN) + (size_t)l * 16384 * 4096};
            pg8::SyncOrder<MTOT, DIN> S; S.init(G, (int)blockIdx.x);
            pg8::EpiIn E{(bf16*)((unsigned char*)da.ws + WS_P), (const float*)((unsigned char*)da.ws + WS_ROPE)};
            int tp = TIDNOW(wk); asm volatile("" : "+v"(tp));
#pragma unroll 1
            for (int rep = 0; rep < ((PROBE_MASK & 2) ? 2 : 1); ++rep) { if (rep) GRID_BAR(); asm volatile("" : "+v"(tp));
            pg8::gemm_phase<pg8::EpiIn, pg8::SyncOrder<MTOT, DIN>, DM>(L, g, S, E, tp); }
            if (BOTH(pb)) GRID_BAR();
        }
        if (IN(pb + 1)) { mixer_phase(da, lds, l, wk); if (PROBE_MASK & 4) { GRID_BAR(); mixer_phase(da, lds, l, wk, 1); } if (BOTH(pb + 1)) GRID_BAR(); }
        if (IN(pb + 2)) {

            pg8::Gemm g{(const bf16*)((unsigned char*)da.ws + WS_Y), (const bf16*)((unsigned char*)da.ws + WS_WOUT) + (size_t)l * 4096 * 4096};
            pg8::SyncOrder<MTOT, DM> S; S.init(G, (int)blockIdx.x);
            pg8::EpiOut E{(bf16*)((unsigned char*)da.ws + WS_H), (const float*)((unsigned char*)da.ws + WS_MOD) + (size_t)l * 9 * 12288};
            int tp = TIDNOW(wk); asm volatile("" : "+v"(tp));
#pragma unroll 1
            for (int rep = 0; rep < (((PROBE_MASK & 8) && l == 0) ? 2 : 1); ++rep) { if (rep) GRID_BAR(); asm volatile("" : "+v"(tp));
            pg8::gemm_phase<pg8::EpiOut, pg8::SyncOrder<MTOT, DM>, DM>(L, g, S, E, tp); }
            if (BOTH(pb + 2)) GRID_BAR();
        }
        if (IN(pb + 3)) { int tp = TIDNOW(wk); asm volatile("" : "+v"(tp)); if (l == 0) ln_phase<false>(da, L, 1, 0, true, 1, tp); else ln_phase<true>(da, L, 1, 1, false, 1, tp); if (BOTH(pb + 3)) GRID_BAR(); }
    }
#undef IN
#undef BOTH
#undef GRID_BAR
}

extern "C" void kernel_launch(void* const* d_in, const int* in_sizes, int n_in, void* d_out, int out_size, void* d_ws, size_t ws_size, hipStream_t stream) {
    static int grid = 0;
    if (grid == 0) {
        if (n_in != 20 || ws_size < WS_END) { fprintf(stderr, "kernel_launch: unexpected n_in %d / ws_size %zu (need %zu)\n", n_in, ws_size, (size_t)WS_END); grid = -1; return; }
        int dev = 0, cus = 0, per_cu = 0;
        if (hipGetDevice(&dev) != hipSuccess || hipDeviceGetAttribute(&cus, hipDeviceAttributeMultiprocessorCount, dev) != hipSuccess) { grid = -1; return; }
        if (hipFuncSetAttribute((const void*)mk_fwd, hipFuncAttributeMaxDynamicSharedMemorySize, LDS_BYTES) != hipSuccess) { fprintf(stderr, "kernel_launch: hipFuncSetAttribute failed\n"); grid = -1; return; }
        if (hipOccupancyMaxActiveBlocksPerMultiprocessor(&per_cu, (const void*)mk_fwd, NWAVES * 64, LDS_BYTES) != hipSuccess || per_cu < 1)
            fprintf(stderr, "kernel_launch: occupancy query reports %d workgroups per CU\n", per_cu);
        (void)hipGetLastError();
        grid = cus;
    }
    if (grid < 0) return;
    if (hipMemsetAsync((char*)d_ws + WS_CTL, 0, CTL_ZERO_BYTES, stream) != hipSuccess) return;
    Args a{};
    for (int i = 0; i < 20; ++i) a.in[i] = (const float*)d_in[i];
    a.out = (float*)d_out; a.ws = (unsigned char*)d_ws;
    if (N_LAUNCHES == 1) { a.ph_lo = 0; a.ph_hi = N_PHASES; hipLaunchKernelGGL(mk_fwd, dim3(grid), dim3(NWAVES * 64), LDS_BYTES, stream, a);
        if (PROBE_RELAUNCH_LO >= 0) { a.ph_lo = PROBE_RELAUNCH_LO; a.ph_hi = PROBE_RELAUNCH_HI; hipLaunchKernelGGL(mk_fwd, dim3(grid), dim3(NWAVES * 64), LDS_BYTES, stream, a); } }
    else for (int p = 0; p < N_PHASES; ++p) { a.ph_lo = p; a.ph_hi = p + 1; hipLaunchKernelGGL(mk_fwd, dim3(grid), dim3(NWAVES * 64), LDS_BYTES, stream, a); }
    const hipError_t le = hipPeekAtLastError();
    if (le != hipSuccess) fprintf(stderr, "kernel_launch: launch failed: %s\n", hipGetErrorName(le));
}
```
